# Optimizing an MI355X kernel written in HIP

```python
import math
import jax, jax.numpy as jnp
from jax import lax
import numpy as np

D_MODEL = 2048
BATCH = 2
SEQ = 4096
DEPTH = 4

GRID_W = 64
CTX_LEN = 256
N_MIXERS = 2
N_S5_LAYERS = (DEPTH + 1) // 2
N_MLA_LAYERS = DEPTH // 2

S5_GROUP = 16
S5_GROUPS = D_MODEL // S5_GROUP
S5_STATE = 64
S5_DT_MIN = 1e-3
S5_DT_MAX = 1e-1

MLA_HEADS = 16
Q_LORA = 512
KV_LORA = 512
QK_NOPE = 128
QK_ROPE = 64
V_HEAD = 128
ROPE_THETA = 10000.0
ATTN_BLOCK = 128

D_FF = 4 * D_MODEL
EPS = 1e-6

kernel_name = "hybrid_s5_mla_dit_trunk"

F32 = jnp.float32


def rmsnorm(x, g):
    xf = x.astype(F32)
    y = xf * lax.rsqrt(jnp.mean(xf * xf, axis=-1, keepdims=True) + EPS)
    return (y * g.astype(F32)).astype(x.dtype)


def sq_relu_mlp(h, w1, w2):
    return jnp.square(jax.nn.relu(h @ w1)) @ w2


def axial_rope_tables(n_tok):
    rows = n_tok // GRID_W
    row = jnp.repeat(jnp.arange(rows, dtype=F32), GRID_W)
    col = jnp.tile(jnp.arange(GRID_W, dtype=F32), rows)
    n_freq = QK_ROPE // 4
    inv = ROPE_THETA ** (-jnp.arange(n_freq, dtype=F32) / n_freq)
    ang = jnp.stack([row[:, None] * inv, col[:, None] * inv], axis=1)
    return jnp.cos(ang), jnp.sin(ang)


def apply_axial_rope(x, cos, sin):
    xs = x.reshape(x.shape[:-1] + (2, 2, QK_ROPE // 4)).astype(F32)
    x1 = xs[..., 0, :]
    x2 = xs[..., 1, :]
    out = jnp.stack([x1 * cos - x2 * sin, x1 * sin + x2 * cos], axis=-2)
    return out.reshape(x.shape).astype(x.dtype)


def mla_queries(h, w_dq, q_norm, w_uq):
    B, L, _ = h.shape
    q = (rmsnorm(h @ w_dq, q_norm) @ w_uq).reshape(B, L, MLA_HEADS, QK_NOPE + QK_ROPE)
    return q[..., :QK_NOPE], q[..., QK_NOPE:]


def mla_keys_values(h, w_dkv, kv_norm, w_ukv):
    B, L, _ = h.shape
    ckv = h @ w_dkv
    kv = (rmsnorm(ckv[..., :KV_LORA], kv_norm) @ w_ukv).reshape(B, L, MLA_HEADS, QK_NOPE + V_HEAD)
    return kv[..., :QK_NOPE], ckv[..., KV_LORA:], kv[..., QK_NOPE:]


def mla_attend(q_nope, q_pe, k_nope, k_pe, v):
    scale = (QK_NOPE + QK_ROPE) ** -0.5
    s = (jnp.einsum('bqhd,bkhd->bhqk', q_nope, k_nope)
         + jnp.einsum('bqhr,bkr->bhqk', q_pe, k_pe)).astype(F32) * scale
    p = jax.nn.softmax(s, axis=-1).astype(v.dtype)
    return jnp.einsum('bhqk,bkhd->bqhd', p, v)


def mla_attend_blocked(q_nope, q_pe, k_nope, k_pe, v):
    B, L = q_nope.shape[:2]
    nb = L // ATTN_BLOCK

    def to_blocks(t):
        return jnp.moveaxis(t.reshape((B, nb, ATTN_BLOCK) + t.shape[2:]), 1, 0)

    out = lax.map(lambda qs: mla_attend(qs[0], qs[1], k_nope, k_pe, v),
                  (to_blocks(q_nope), to_blocks(q_pe)))
    return jnp.moveaxis(out, 0, 1).reshape(B, L, MLA_HEADS, V_HEAD)


def mla_mixer(h_lat, h_ctx, cos, sin, w_dq, q_norm, w_uq, w_dkv, kv_norm, w_ukv, w_o, need_ctx):
    B, L, _ = h_lat.shape
    qn, qp = mla_queries(h_lat, w_dq, q_norm, w_uq)
    qp = apply_axial_rope(qp, cos[:, None], sin[:, None])
    kn, kp, v = mla_keys_values(h_lat, w_dkv, kv_norm, w_ukv)
    kp = apply_axial_rope(kp, cos, sin)
    ckn, ckp, cv = mla_keys_values(h_ctx, w_dkv, kv_norm, w_ukv)
    kn_all = jnp.concatenate([ckn, kn], axis=1)
    kp_all = jnp.concatenate([ckp, kp], axis=1)
    v_all = jnp.concatenate([cv, v], axis=1)
    o_lat = mla_attend_blocked(qn, qp, kn_all, kp_all, v_all).reshape(B, L, MLA_HEADS * V_HEAD) @ w_o
    if not need_ctx:
        return o_lat, None
    cqn, cqp = mla_queries(h_ctx, w_dq, q_norm, w_uq)
    o_ctx = mla_attend(cqn, cqp, ckn, ckp, cv).reshape(B, h_ctx.shape[1], MLA_HEADS * V_HEAD) @ w_o
    return o_lat, o_ctx


def s5_discretize(lam_re, lam_im, log_dt, b_re, b_im):
    lam_re = lam_re.astype(F32)
    lam_im = lam_im.astype(F32)
    dt = jnp.exp(log_dt.astype(F32))[:, None]
    mag = jnp.exp(lam_re * dt)
    lbr = mag * jnp.cos(lam_im * dt)
    lbi = mag * jnp.sin(lam_im * dt)
    nr = lbr - 1.0
    den = lam_re * lam_re + lam_im * lam_im
    fr = (nr * lam_re + lbi * lam_im) / den
    fi = (lbi * lam_re - nr * lam_im) / den
    b_re = b_re.astype(F32)
    b_im = b_im.astype(F32)
    bbr = fr[..., None] * b_re - fi[..., None] * b_im
    bbi = fr[..., None] * b_im + fi[..., None] * b_re
    return lbr, lbi, bbr, bbi


def _linrec_combine(e1, e2):
    a1r, a1i, b1r, b1i = e1
    a2r, a2i, b2r, b2i = e2
    return (a2r * a1r - a2i * a1i,
            a2r * a1i + a2i * a1r,
            a2r * b1r - a2i * b1i + b2r,
            a2r * b1i + a2i * b1r + b2i)


def s5_scan(u, lbr, lbi, bbr, bbi, h0r, h0i, reverse):
    bur = jnp.einsum('blgc,gpc->blgp', u, bbr)
    bui = jnp.einsum('blgc,gpc->blgp', u, bbi)
    if h0r is not None:
        first = -1 if reverse else 0
        bur = bur.at[:, first].add(lbr * h0r - lbi * h0i)
        bui = bui.at[:, first].add(lbr * h0i + lbi * h0r)
    L = u.shape[1]
    ar = jnp.broadcast_to(lbr, (1, L) + lbr.shape)
    ai = jnp.broadcast_to(lbi, (1, L) + lbi.shape)
    _, _, hr, hi = lax.associative_scan(_linrec_combine, (ar, ai, bur, bui), axis=1, reverse=reverse)
    return hr, hi


def s5_readout(hr, hi, c_re, c_im):
    return (jnp.einsum('blgp,gcp->blgc', hr, c_re.astype(F32))
            - jnp.einsum('blgp,gcp->blgc', hi, c_im.astype(F32)))


def s5_glu(y, w_glu, b_glu):
    z = jax.nn.gelu(y)
    return z * jax.nn.sigmoid(z @ w_glu.astype(F32) + b_glu.astype(F32))


def s5_mixer(h_lat, h_ctx, lam_re, lam_im, log_dt, b_re, b_im, c_re, c_im, d_skip, w_glu, b_glu, need_ctx):
    B, L, D = h_lat.shape
    Lc = h_ctx.shape[1]
    u_lat = h_lat.astype(F32).reshape(B, L, S5_GROUPS, S5_GROUP)
    u_ctx = h_ctx.astype(F32).reshape(B, Lc, S5_GROUPS, S5_GROUP)
    d_g = d_skip.astype(F32).reshape(S5_GROUPS, S5_GROUP)
    y_lat = d_g * u_lat
    y_ctx = d_g * u_ctx if need_ctx else None
    for direction in range(2):
        rev = direction == 1
        disc = s5_discretize(lam_re[direction], lam_im[direction], log_dt[direction],
                             b_re[direction], b_im[direction])
        cr, ci = s5_scan(u_ctx, *disc, None, None, rev)
        fin = 0 if rev else -1
        hr, hi = s5_scan(u_lat, *disc, cr[:, fin], ci[:, fin], rev)
        y_lat = y_lat + s5_readout(hr, hi, c_re[direction], c_im[direction])
        if need_ctx:
            y_ctx = y_ctx + s5_readout(cr, ci, c_re[direction], c_im[direction])
    o_lat = s5_glu(y_lat.reshape(B, L, D), w_glu, b_glu).astype(h_lat.dtype)
    if not need_ctx:
        return o_lat, None
    o_ctx = s5_glu(y_ctx.reshape(B, Lc, D), w_glu, b_glu).astype(h_ctx.dtype)
    return o_lat, o_ctx


def setup_inputs(seed: int = 0) -> dict:
    key = jax.random.key(seed)
    ks = jax.random.split(key, 40)

    def nrm(k, shape, scale):
        return jax.random.normal(k, shape, F32) * scale

    G, P = S5_GROUPS, S5_STATE
    n_idx = jnp.arange(P, dtype=F32)
    inp = {}
    inp["x"] = nrm(ks[0], (BATCH, SEQ, D_MODEL), 1.0)
    inp["c"] = nrm(ks[1], (BATCH, D_MODEL), 1.0)
    inp["ctx"] = nrm(ks[2], (BATCH, CTX_LEN, D_MODEL), 1.0)
    inp["c_ctx"] = nrm(ks[3], (D_MODEL,), 1.0)
    inp["ada_w"] = nrm(ks[4], (DEPTH, D_MODEL, 6 * D_MODEL), 0.5 * D_MODEL ** -0.5)
    inp["ada_b"] = nrm(ks[5], (DEPTH, 6 * D_MODEL), 0.02)
    inp["norm1_g"] = 1.0 + nrm(ks[6], (DEPTH, D_MODEL), 0.05)
    inp["norm2_g"] = 1.0 + nrm(ks[7], (DEPTH, D_MODEL), 0.05)
    inp["final_norm_g"] = 1.0 + nrm(ks[8], (D_MODEL,), 0.05)
    inp["s5_lam_re"] = -0.5 + nrm(ks[9], (N_S5_LAYERS, 2, G, P), 0.01)
    inp["s5_lam_im"] = math.pi * n_idx + nrm(ks[10], (N_S5_LAYERS, 2, G, P), 0.01)
    inp["s5_log_dt"] = jax.random.uniform(ks[11], (N_S5_LAYERS, 2, G), F32,
                                          math.log(S5_DT_MIN), math.log(S5_DT_MAX))
    inp["s5_b_re"] = nrm(ks[12], (N_S5_LAYERS, 2, G, P, S5_GROUP), (2 * S5_GROUP) ** -0.5)
    inp["s5_b_im"] = nrm(ks[13], (N_S5_LAYERS, 2, G, P, S5_GROUP), (2 * S5_GROUP) ** -0.5)
    inp["s5_c_re"] = nrm(ks[14], (N_S5_LAYERS, 2, G, S5_GROUP, P), (2 * P) ** -0.5)
    inp["s5_c_im"] = nrm(ks[15], (N_S5_LAYERS, 2, G, S5_GROUP, P), (2 * P) ** -0.5)
    inp["s5_d"] = nrm(ks[16], (N_S5_LAYERS, D_MODEL), 0.5)
    inp["s5_w_glu"] = nrm(ks[17], (N_S5_LAYERS, D_MODEL, D_MODEL), D_MODEL ** -0.5)
    inp["s5_b_glu"] = nrm(ks[18], (N_S5_LAYERS, D_MODEL), 0.02)
    inp["mla_w_dq"] = nrm(ks[19], (N_MLA_LAYERS, D_MODEL, Q_LORA), D_MODEL ** -0.5)
    inp["mla_q_norm"] = 1.0 + nrm(ks[20], (N_MLA_LAYERS, Q_LORA), 0.05)
    inp["mla_w_uq"] = nrm(ks[21], (N_MLA_LAYERS, Q_LORA, MLA_HEADS * (QK_NOPE + QK_ROPE)), Q_LORA ** -0.5)
    inp["mla_w_dkv"] = nrm(ks[22], (N_MLA_LAYERS, D_MODEL, KV_LORA + QK_ROPE), D_MODEL ** -0.5)
    inp["mla_kv_norm"] = 1.0 + nrm(ks[23], (N_MLA_LAYERS, KV_LORA), 0.05)
    inp["mla_w_ukv"] = nrm(ks[24], (N_MLA_LAYERS, KV_LORA, MLA_HEADS * (QK_NOPE + V_HEAD)), KV_LORA ** -0.5)
    inp["mla_w_o"] = nrm(ks[25], (N_MLA_LAYERS, MLA_HEADS * V_HEAD, D_MODEL), (MLA_HEADS * V_HEAD) ** -0.5)
    inp["ffn_w1"] = nrm(ks[26], (DEPTH, D_MODEL, D_FF), D_MODEL ** -0.5)
    inp["ffn_w2"] = nrm(ks[27], (DEPTH, D_FF, D_MODEL), D_FF ** -0.5)
    return inp


def reference(x, c, ctx, c_ctx, ada_w, ada_b, norm1_g, norm2_g, final_norm_g,
              s5_lam_re, s5_lam_im, s5_log_dt, s5_b_re, s5_b_im, s5_c_re, s5_c_im,
              s5_d, s5_w_glu, s5_b_glu,
              mla_w_dq, mla_q_norm, mla_w_uq, mla_w_dkv, mla_kv_norm, mla_w_ukv, mla_w_o,
              ffn_w1, ffn_w2):
    B, L, _ = x.shape
    cos, sin = axial_rope_tables(L)
    s_lat = jax.nn.silu(c)
    s_ctx = jax.nn.silu(c_ctx)
    h_ctx = ctx
    for i in range(DEPTH):
        last = i == DEPTH - 1
        j = i // N_MIXERS
        sh1, sc1, g1, sh2, sc2, g2 = jnp.split((s_lat @ ada_w[i] + ada_b[i])[:, None, :], 6, axis=-1)
        csh1, csc1, cg1, csh2, csc2, cg2 = jnp.split(s_ctx @ ada_w[i] + ada_b[i], 6, axis=-1)
        a_lat = rmsnorm(x, norm1_g[i]) * (1.0 + sc1) + sh1
        a_ctx = rmsnorm(h_ctx, norm1_g[i]) * (1.0 + csc1) + csh1
        if i % N_MIXERS == 0:
            m_lat, m_ctx = s5_mixer(a_lat, a_ctx, s5_lam_re[j], s5_lam_im[j], s5_log_dt[j],
                                    s5_b_re[j], s5_b_im[j], s5_c_re[j], s5_c_im[j],
                                    s5_d[j], s5_w_glu[j], s5_b_glu[j], not last)
        else:
            m_lat, m_ctx = mla_mixer(a_lat, a_ctx, cos, sin, mla_w_dq[j], mla_q_norm[j], mla_w_uq[j],
                                     mla_w_dkv[j], mla_kv_norm[j], mla_w_ukv[j], mla_w_o[j], not last)
        x = x + g1 * m_lat
        x = x + g2 * sq_relu_mlp(rmsnorm(x, norm2_g[i]) * (1.0 + sc2) + sh2, ffn_w1[i], ffn_w2[i])
        if not last:
            h_ctx = h_ctx + cg1 * m_ctx
            h_ctx = h_ctx + cg2 * sq_relu_mlp(rmsnorm(h_ctx, norm2_g[i]) * (1.0 + csc2) + csh2,
                                             ffn_w1[i], ffn_w2[i])
    return rmsnorm(x, final_norm_g)
```

```cpp
#include <hip/hip_runtime.h>
#include <stdint.h>
#include <cstdio>
#include <cstring>

#define LAS __attribute__((address_space(3)))
typedef unsigned short bf16_t;
typedef short bf16x8 __attribute__((ext_vector_type(8)));
typedef float f32x4 __attribute__((ext_vector_type(4)));
typedef float f32x2 __attribute__((ext_vector_type(2)));
typedef unsigned u32x4 __attribute__((ext_vector_type(4)));
typedef unsigned u32x2 __attribute__((ext_vector_type(2)));

constexpr int DM = 2048, NB = 2, SEQ = 4096, CTX = 256, DEPTH = 4, DFF = 8192;
constexpr int NLAT = NB * SEQ, NCTX = NB * CTX, MROWS = NLAT + NCTX;
constexpr int NKEY = CTX + SEQ;
constexpr int NG = 128, NP = 64, GC = 16;
constexpr int NH = 16, QL = 512, KVL = 512, DN = 128, DR = 64, DV = 128, DQK = DN + DR;
constexpr int NDQKV = 1280;
constexpr float EPS = 1e-6f;

constexpr size_t al256(size_t x) { return (x + 255) & ~(size_t)255; }
constexpr size_t OFF_BAR = 0;
constexpr size_t OFF_MOD = 16384;
constexpr size_t OFF_ROPE = OFF_MOD + al256((size_t)DEPTH * 3 * 6 * DM * 4);
constexpr size_t OFF_LAMB = OFF_ROPE + al256((size_t)SEQ * 2 * 16 * 2 * 4);
constexpr size_t OFF_BBAR = OFF_LAMB + al256((size_t)2 * 2 * NG * NP * 2 * 4);
constexpr size_t OFF_XS = OFF_BBAR + al256((size_t)2 * 2 * NG * NP * GC * 2 * 4);
constexpr size_t OFF_ABUF = OFF_XS + al256((size_t)MROWS * DM * 4);
constexpr size_t OFF_ZBUF = OFF_ABUF + al256((size_t)MROWS * DM * 2);
constexpr size_t OFF_HBUF = OFF_ZBUF + al256((size_t)MROWS * DM * 2);
constexpr size_t OFF_YF = OFF_HBUF + al256((size_t)MROWS * DFF * 2);
constexpr size_t OFF_YB = OFF_YF + al256((size_t)MROWS * DM * 4);
constexpr size_t OFF_QC = OFF_YB + al256((size_t)MROWS * DM * 4);
constexpr size_t OFF_QN = OFF_QC + al256((size_t)MROWS * NDQKV * 4);
constexpr size_t OFF_CKVN = OFF_QN + al256((size_t)MROWS * QL * 2);
constexpr size_t OFF_KPE = OFF_CKVN + al256((size_t)MROWS * KVL * 2);
constexpr size_t OFF_Q = OFF_KPE + al256((size_t)NB * NKEY * DR * 2);
constexpr size_t OFF_K = OFF_Q + al256((size_t)NB * NH * NKEY * DQK * 2);
constexpr size_t OFF_V = OFF_K + al256((size_t)NB * NH * NKEY * DN * 2);
constexpr size_t OFF_W1T = OFF_V + al256((size_t)NB * NH * NKEY * DV * 2);
constexpr size_t OFF_W2T = OFF_W1T + (size_t)DEPTH * DFF * DM * 2;
constexpr size_t OFF_WGLUT = OFF_W2T + (size_t)DEPTH * DFF * DM * 2;
constexpr size_t OFF_WOT = OFF_WGLUT + (size_t)2 * DM * DM * 2;
constexpr size_t OFF_WDQKVT = OFF_WOT + (size_t)2 * DM * DM * 2;
constexpr size_t OFF_WUQT = OFF_WDQKVT + (size_t)2 * NDQKV * DM * 2;
constexpr size_t OFF_WUKVT = OFF_WUQT + (size_t)2 * NH * DQK * QL * 2;
constexpr size_t WS_END = OFF_WUKVT + (size_t)2 * NH * (DN + DV) * KVL * 2;

__device__ __forceinline__ float bf2f(bf16_t b) { return __uint_as_float(((unsigned)b) << 16); }
__device__ __forceinline__ bf16_t f2bf(float f) { unsigned u = __float_as_uint(f); u += 0x7FFFu + ((u >> 16) & 1u); return (bf16_t)(u >> 16); }
__device__ __forceinline__ unsigned pk2(float lo, float hi) { return (unsigned)f2bf(lo) | ((unsigned)f2bf(hi) << 16); }
__device__ __forceinline__ float wave_sum(float v) {
#pragma unroll
    for (int o = 32; o >= 1; o >>= 1) v += __shfl_xor(v, o);
    return v;
}
__device__ __forceinline__ float sigmoidf_(float x) { return 1.0f / (1.0f + __expf(-x)); }
__device__ __forceinline__ float gelu_tanh(float x) { const float u = 0.7978845608028654f * (x + 0.044715f * x * x * x); return 0.5f * x * (1.0f + tanhf(u)); }
__device__ __forceinline__ void sincos_d(double a, double& s, double& c) {
    const double kd = rint(a * 0.63661977236758134308);
    double r = fma(-kd, 1.57079632679489655800e+00, a); r = fma(-kd, 6.12323399573676603587e-17, r);
    const long long k = (long long)kd; const double r2 = r * r;
    const double sp = r * (1.0 + r2 * (-1.0 / 6 + r2 * (1.0 / 120 + r2 * (-1.0 / 5040 + r2 * (1.0 / 362880 + r2 * (-1.0 / 39916800 + r2 * (1.0 / 6227020800.0)))))));
    const double cp = 1.0 + r2 * (-0.5 + r2 * (1.0 / 24 + r2 * (-1.0 / 720 + r2 * (1.0 / 40320 + r2 * (-1.0 / 3628800 + r2 * (1.0 / 479001600.0 + r2 * (-1.0 / 87178291200.0)))))));
    const int q = (int)(k & 3);
    s = (q == 0) ? sp : (q == 1) ? cp : (q == 2) ? -sp : -cp;
    c = (q == 0) ? cp : (q == 1) ? -sp : (q == 2) ? -cp : sp;
}
__device__ __forceinline__ int rope_srcd(int dp) { return (dp & 32) + (dp & 1) * 16 + ((dp & 31) >> 1); }

namespace pg8 {
constexpr int BM = 256, BK = 64, HALF = 128, HTB = HALF * BK * 2, STAGE_BYTES = 8 * HTB, NXCD = 8, WGM = 8;
__host__ __device__ __forceinline__ int lds_byte(int r, int c) { const int st = (r >> 4) * 2 + (c >> 5), rr = r & 15, cc = c & 31, ob = rr * 64 + cc * 2; return st * 1024 + (ob ^ (((ob >> 9) & 1) << 5)); }
__host__ __device__ __forceinline__ void stage_rc(int b, int& R, int& C) { const int st = b / 1024, sb = b % 1024, swz = sb ^ (((sb >> 9) & 1) << 5); R = (st >> 1) * 16 + swz / 64; C = (st & 1) * 32 + (swz % 64) / 2; }
__host__ __device__ __forceinline__ int perm32(int rho) { const int n = rho >> 4, i = rho & 15; return 8 * (i >> 2) + 4 * n + (i & 3); }
struct Unit { int pm, pn; };
struct Gemm { const bf16_t* A; const bf16_t* Bt; int M, N, K; };
struct StaticOrder {
    int nM, nN, nwg, G, c;
    __host__ __device__ void init(int M, int N, int G_, int c_) { nM = M / BM; nN = N / BM; nwg = nM * nN; G = G_; c = c_; }
    __host__ __device__ bool next(int i, Unit& u) const {
        const long L = (long)i * G + c; if (L >= nwg) return false;
        int wgid = (int)L; { const int q = nwg / NXCD, r = nwg % NXCD, xcd = wgid % NXCD, off = wgid / NXCD; wgid = (xcd < r ? xcd * (q + 1) : r * (q + 1) + (xcd - r) * q) + off; }
        const int nig = WGM * nN, gid = wgid / nig, fm = gid * WGM, gsz = (nM - fm) < WGM ? (nM - fm) : WGM;
        u.pm = fm + ((wgid % nig) % gsz); u.pn = (wgid % nig) / gsz; return true;
    }
    __device__ __forceinline__ void a_ready(const Unit&) const {}
    __device__ __forceinline__ void done(const Unit&) const {}
};
template <class Epi, class Sched>
__device__ __forceinline__ void gemm_phase(LAS unsigned char* lds, const Gemm g, const Sched& S, const Epi& E) {
    const int tid = threadIdx.x, wid = __builtin_amdgcn_readfirstlane(tid >> 6), lane = tid & 63, wr = wid >> 2, wc = wid & 3, fr = lane & 15, fq = lane >> 4;
    const int K = g.K, nt = K / BK;
    unsigned voffA[2], voffB[2];
#pragma unroll
    for (int i = 0; i < 2; ++i) { int R, C; stage_rc(tid * 16 + i * 8192, R, C); const int Rb = Epi::PERM ? ((R & ~31) + perm32(R & 31)) : R;
        voffA[i] = (unsigned)(R * K + C) * 2u; voffB[i] = (unsigned)(Rb * K + C) * 2u; }
    const size_t kstep = (size_t)(BK * 2);
    const size_t hstep = (size_t)HALF * K * 2;
    const size_t tstep = 2 * hstep;
    const unsigned ldsw = (unsigned)wid * 1024u;
    const int aoff = lds_byte(wr * 64 + fr, fq * 8), boff = lds_byte(wc * 32 + fr, fq * 8);
#define PG8_SA(b, h) (((b) * 2 + (h)) * HTB)
#define PG8_SB(b, h) ((4 + (b) * 2 + (h)) * HTB)
#define PG8_STAGE(bufoff, gbase, voff) do { _Pragma("unroll") for (int _i = 0; _i < 2; ++_i) \
        __builtin_amdgcn_global_load_lds((const unsigned*)((const char*)(gbase) + (voff)[_i]), (LAS unsigned*)(lds + (bufoff) + ldsw + _i * 8192), 16, 0, 0); } while (0)
#define PG8_LDA(dst, b, h) do { _Pragma("unroll") for (int m = 0; m < 4; ++m) _Pragma("unroll") for (int k = 0; k < 2; ++k) dst[m][k] = *(const LAS bf16x8*)(lds + PG8_SA(b, h) + aoff + m * 2048 + k * 1024); } while (0)
#define PG8_LDB(dst, b, h) do { _Pragma("unroll") for (int n = 0; n < 2; ++n) _Pragma("unroll") for (int k = 0; k < 2; ++k) dst[n][k] = *(const LAS bf16x8*)(lds + PG8_SB(b, h) + boff + n * 2048 + k * 1024); } while (0)
#define PG8_MMA(ai, bj, At, Bt) do { __builtin_amdgcn_s_setprio(1); _Pragma("unroll") for (int m = 0; m < 4; ++m) _Pragma("unroll") for (int n = 0; n < 2; ++n) _Pragma("unroll") for (int k = 0; k < 2; ++k) \
        acc[ai][bj][m][n] = __builtin_amdgcn_mfma_f32_16x16x32_bf16(Bt[n][k], At[m][k], acc[ai][bj][m][n], 0, 0, 0); __builtin_amdgcn_s_setprio(0); } while (0)
#define PG8_WAIT_V(n) asm volatile("s_waitcnt vmcnt(" #n ")" ::: "memory")
#define PG8_WAIT_L(n) asm volatile("s_waitcnt lgkmcnt(" #n ")" ::: "memory")
#define PG8_BAR __builtin_amdgcn_s_barrier()
#define PG8_SCHED __builtin_amdgcn_sched_barrier(0)
    Unit cur, nxt; int ui = 0;
    if (!S.next(0, cur)) return;
    f32x4 acc[2][2][4][2];
#pragma unroll
    for (int a = 0; a < 2; ++a)
#pragma unroll
        for (int b = 0; b < 2; ++b)
#pragma unroll
            for (int m = 0; m < 4; ++m)
#pragma unroll
                for (int n = 0; n < 2; ++n) acc[a][b][m][n] = (f32x4){0.f, 0.f, 0.f, 0.f};
    bf16x8 At[4][2], B0[2][2], B1[2][2];
    const char* cA = (const char*)g.A + (size_t)cur.pm * tstep; const char* cB = (const char*)g.Bt + (size_t)cur.pn * tstep;
    S.a_ready(cur);
    PG8_STAGE(PG8_SB(0, 0), cB, voffB); PG8_STAGE(PG8_SA(0, 0), cA, voffA); PG8_STAGE(PG8_SB(0, 1), cB + hstep, voffB); PG8_STAGE(PG8_SA(0, 1), cA + hstep, voffA);
    if (wr == 1) PG8_BAR;
    PG8_WAIT_V(4); PG8_BAR;
    PG8_STAGE(PG8_SB(1, 0), cB + kstep, voffB); PG8_STAGE(PG8_SA(1, 0), cA + kstep, voffA); PG8_STAGE(PG8_SB(1, 1), cB + hstep + kstep, voffB);
    PG8_WAIT_V(6); PG8_BAR;
    for (;;) {
        const bool has_next = S.next(ui + 1, nxt);
        const char* nA = has_next ? (const char*)g.A + (size_t)nxt.pm * tstep : cA; const char* nB = has_next ? (const char*)g.Bt + (size_t)nxt.pn * tstep : cB;
        for (int t = 0; t < nt; t += 2) {
            const bool last = (t == nt - 2);
            const char* a1 = cA + (size_t)(t + 1) * kstep;
            const char* a2 = last ? nA : cA + (size_t)(t + 2) * kstep; const char* b2 = last ? nB : cB + (size_t)(t + 2) * kstep;
            const char* a3 = a2 + kstep; const char* b3 = b2 + kstep;
            if (last && has_next) S.a_ready(nxt);
            PG8_LDB(B0, 0, 0); PG8_SCHED; PG8_LDA(At, 0, 0); PG8_STAGE(PG8_SA(1, 1), a1 + hstep, voffA);
            PG8_WAIT_L(8); PG8_BAR; PG8_WAIT_L(0); PG8_MMA(0, 0, At, B0); PG8_BAR; PG8_SCHED;
            PG8_LDB(B1, 0, 1); PG8_STAGE(PG8_SB(0, 0), b2, voffB);
            PG8_BAR; PG8_WAIT_L(0); PG8_MMA(0, 1, At, B1); PG8_BAR;
            PG8_LDA(At, 0, 1); PG8_STAGE(PG8_SA(0, 0), a2, voffA);
            PG8_BAR; PG8_WAIT_L(0); PG8_MMA(1, 0, At, B0); PG8_BAR; PG8_SCHED;
            PG8_STAGE(PG8_SB(0, 1), b2 + hstep, voffB);
            PG8_WAIT_V(6); PG8_BAR; PG8_MMA(1, 1, At, B1); PG8_BAR;
            PG8_LDB(B0, 1, 0); PG8_SCHED; PG8_LDA(At, 1, 0); PG8_STAGE(PG8_SA(0, 1), a2 + hstep, voffA);
            PG8_WAIT_L(8); PG8_BAR; PG8_WAIT_L(0); PG8_MMA(0, 0, At, B0); PG8_BAR; PG8_SCHED;
            PG8_LDB(B1, 1, 1); PG8_STAGE(PG8_SB(1, 0), b3, voffB);
            PG8_BAR; PG8_WAIT_L(0); PG8_MMA(0, 1, At, B1); PG8_BAR;
            PG8_LDA(At, 1, 1); PG8_STAGE(PG8_SA(1, 0), a3, voffA);
            PG8_BAR; PG8_WAIT_L(0); PG8_MMA(1, 0, At, B0); PG8_BAR; PG8_SCHED;
            PG8_STAGE(PG8_SB(1, 1), b3 + hstep, voffB);
            PG8_WAIT_V(6); PG8_BAR; PG8_MMA(1, 1, At, B1); PG8_BAR;
        }
        E(acc, cur, wr, wc, fr, fq); S.done(cur);
        if (!has_next) break;
#pragma unroll
        for (int a = 0; a < 2; ++a)
#pragma unroll
            for (int b = 0; b < 2; ++b)
#pragma unroll
                for (int m = 0; m < 4; ++m)
#pragma unroll
                    for (int n = 0; n < 2; ++n) acc[a][b][m][n] = (f32x4){0.f, 0.f, 0.f, 0.f};
        cur = nxt; cA = nA; cB = nB; ++ui;
    }
    PG8_WAIT_V(0);
    if (wr == 0) PG8_BAR;
    PG8_BAR;
#undef PG8_SA
#undef PG8_SB
#undef PG8_STAGE
#undef PG8_LDA
#undef PG8_LDB
#undef PG8_MMA
#undef PG8_WAIT_V
#undef PG8_WAIT_L
#undef PG8_BAR
#undef PG8_SCHED
}
}

template <class F> struct Epi4 {
    static constexpr bool PERM = false, AFTER_DRAIN = false; F f;
    __device__ __forceinline__ void operator()(const f32x4 (&acc)[2][2][4][2], const pg8::Unit& u, int wr, int wc, int fr, int fq) const {
#pragma unroll
        for (int ai = 0; ai < 2; ++ai)
#pragma unroll
            for (int m = 0; m < 4; ++m) { const int row = u.pm * 256 + ai * 128 + wr * 64 + m * 16 + fr;
#pragma unroll
                for (int bj = 0; bj < 2; ++bj)
#pragma unroll
                    for (int n = 0; n < 2; ++n) f(row, u.pn * 256 + bj * 128 + wc * 32 + n * 16 + 4 * fq, acc[ai][bj][m][n]); }
    }
};
template <class F> struct Epi8 {
    static constexpr bool PERM = true, AFTER_DRAIN = false; F f;
    __device__ __forceinline__ void operator()(const f32x4 (&acc)[2][2][4][2], const pg8::Unit& u, int wr, int wc, int fr, int fq) const {
#pragma unroll
        for (int ai = 0; ai < 2; ++ai)
#pragma unroll
            for (int m = 0; m < 4; ++m) { const int row = u.pm * 256 + ai * 128 + wr * 64 + m * 16 + fr;
#pragma unroll
                for (int bj = 0; bj < 2; ++bj) f(row, u.pn * 256 + bj * 128 + wc * 32 + 8 * fq, acc[ai][bj][m][0], acc[ai][bj][m][1]); }
    }
};
__device__ __forceinline__ int modrow(int row) { return row < NLAT ? (row >> 12) : 2; }
struct FRes { float* xs; const float* g;
    __device__ __forceinline__ void operator()(int row, int col, f32x4 v) const {
        float* p = xs + (size_t)row * DM + col; const f32x4 gg = *(const f32x4*)(g + modrow(row) * 6 * DM + col);
        f32x4 x = *(const f32x4*)p; x += gg * v; *(f32x4*)p = x; } };
struct FGlu { float* xs; const float* g; const bf16_t* z; const float* bglu;
    __device__ __forceinline__ void operator()(int row, int col, f32x4 v) const {
        float* p = xs + (size_t)row * DM + col; const f32x4 gg = *(const f32x4*)(g + modrow(row) * 6 * DM + col); const f32x4 bb = *(const f32x4*)(bglu + col);
        const u32x2 zz = *(const u32x2*)(z + (size_t)row * DM + col);
        const float z0 = __uint_as_float(zz.x << 16), z1 = __uint_as_float(zz.x & 0xffff0000u), z2 = __uint_as_float(zz.y << 16), z3 = __uint_as_float(zz.y & 0xffff0000u);
        f32x4 x = *(const f32x4*)p;
        x[0] += gg[0] * z0 * sigmoidf_(v[0] + bb[0]); x[1] += gg[1] * z1 * sigmoidf_(v[1] + bb[1]);
        x[2] += gg[2] * z2 * sigmoidf_(v[2] + bb[2]); x[3] += gg[3] * z3 * sigmoidf_(v[3] + bb[3]);
        *(f32x4*)p = x; } };
struct FUp { bf16_t* h;
    __device__ __forceinline__ void operator()(int row, int col, f32x4 a, f32x4 b) const {
        f32x4 r0 = __builtin_elementwise_max(a, (f32x4){0.f, 0.f, 0.f, 0.f}), r1 = __builtin_elementwise_max(b, (f32x4){0.f, 0.f, 0.f, 0.f}); r0 *= r0; r1 *= r1;
        u32x4 w; w.x = pk2(r0[0], r0[1]); w.y = pk2(r0[2], r0[3]); w.z = pk2(r1[0], r1[1]); w.w = pk2(r1[2], r1[3]);
        *(u32x4*)(h + (size_t)row * DFF + col) = w; } };
struct FF32 { float* C; int ldc;
    __device__ __forceinline__ void operator()(int row, int col, f32x4 v) const { *(f32x4*)(C + (size_t)row * ldc + col) = v; } };
__device__ __forceinline__ void row_bk(int row, int& b, int& key, int& lpos) {
    if (row < NLAT) { b = row >> 12; lpos = row & (SEQ - 1); key = CTX + lpos; } else { const int r = row - NLAT; b = r >> 8; key = r & (CTX - 1); lpos = -1; } }
struct FUq { bf16_t* Q; const float* rope; float qscale;
    __device__ __forceinline__ void operator()(int row, int col, f32x4 a, f32x4 b) const {
        int bb, key, lpos; row_bk(row, bb, key, lpos);
        const int h = col / DQK, e = col - h * DQK;
        if (e >= DN && lpos >= 0) { const int ep = e - DN, axis = ep >> 5, f0 = (ep & 31) >> 1;
            const f32x4 cs0 = *(const f32x4*)(rope + ((size_t)(lpos * 2 + axis) * 16 + f0) * 2), cs1 = *(const f32x4*)(rope + ((size_t)(lpos * 2 + axis) * 16 + f0 + 2) * 2);
            f32x4 na, nb;
            na[0] = a[0] * cs0[0] - a[1] * cs0[1]; na[1] = a[0] * cs0[1] + a[1] * cs0[0]; na[2] = a[2] * cs0[2] - a[3] * cs0[3]; na[3] = a[2] * cs0[3] + a[3] * cs0[2];
            nb[0] = b[0] * cs1[0] - b[1] * cs1[1]; nb[1] = b[0] * cs1[1] + b[1] * cs1[0]; nb[2] = b[2] * cs1[2] - b[3] * cs1[3]; nb[3] = b[2] * cs1[3] + b[3] * cs1[2];
            a = na; b = nb; }
        a *= qscale; b *= qscale;
        u32x4 w; w.x = pk2(a[0], a[1]); w.y = pk2(a[2], a[3]); w.z = pk2(b[0], b[1]); w.w = pk2(b[2], b[3]);
        *(u32x4*)(Q + ((size_t)(bb * NH + h) * NKEY + key) * DQK + e) = w; } };
struct FUkv { bf16_t* Kb; bf16_t* Vb;
    __device__ __forceinline__ void operator()(int row, int col, f32x4 a, f32x4 b) const {
        int bb, key, lpos; row_bk(row, bb, key, lpos);
        const int h = col >> 8, e = col & 255;
        u32x4 w; w.x = pk2(a[0], a[1]); w.y = pk2(a[2], a[3]); w.z = pk2(b[0], b[1]); w.w = pk2(b[2], b[3]);
        bf16_t* dst = (e < DN ? Kb : Vb) + ((size_t)(bb * NH + h) * NKEY + key) * DN + (e & 127);
        *(u32x4*)dst = w; } };

template <class Epi> __global__ __launch_bounds__(512, 2) void k_gemm(pg8::Gemm g, Epi E) {
    extern __shared__ __attribute__((aligned(16))) unsigned char shm[];
    pg8::StaticOrder S; S.init(g.M, g.N, (int)gridDim.x, (int)blockIdx.x);
    pg8::gemm_phase<Epi, pg8::StaticOrder>((LAS unsigned char*)shm, g, S, E);
}

struct CvtDesc { const float* src0; const float* src1; int ld0, ld1, K, mode; bf16_t* dst; int pad_; };
__global__ __launch_bounds__(256) void k_cvt(CvtDesc d) {
    __shared__ float tile[64][65];
    const int tid = threadIdx.x, k0 = blockIdx.x * 64, n0 = blockIdx.y * 64;
    { const int n = n0 + (tid & 63); const float* sp = nullptr; int ld = 0;
      if (d.mode == 0) { sp = d.src0 + n; ld = d.ld0; }
      else if (d.mode == 1) { if (n < 512) { sp = d.src0 + n; ld = d.ld0; } else if (n < 1024) { sp = d.src1 + (n - 512); ld = d.ld1; } else if (n < 1088) { sp = d.src1 + 512 + rope_srcd(n - 1024); ld = d.ld1; } }
      else { const int h = n / DQK, e = n - h * DQK; sp = d.src0 + (e < DN ? n : h * DQK + DN + rope_srcd(e - DN)); ld = d.ld0; }
#pragma unroll
      for (int i = 0; i < 16; ++i) { const int k = i * 4 + (tid >> 6); tile[k][tid & 63] = sp ? sp[(size_t)(k0 + k) * ld] : 0.f; } }
    __syncthreads();
#pragma unroll
    for (int i = 0; i < 2; ++i) { const int idx = tid + i * 256, n = idx >> 3, kc = (idx & 7) * 8;
        u32x4 w; w.x = pk2(tile[kc][n], tile[kc + 1][n]); w.y = pk2(tile[kc + 2][n], tile[kc + 3][n]); w.z = pk2(tile[kc + 4][n], tile[kc + 5][n]); w.w = pk2(tile[kc + 6][n], tile[kc + 7][n]);
        *(u32x4*)(d.dst + (size_t)(n0 + n) * d.K + k0 + kc) = w; }
}
__device__ __forceinline__ void ada_unit(int u, const float* c, const float* cctx, const float* ada_w, const float* ada_b, float* mod, float* sl  , float* red  ) {
    const int tid = threadIdx.x, w = tid >> 6, l = tid & 63, cq = l & 15, ko = l >> 4;
    const int layer = u / 192, col0 = (u % 192) * 64;
    float acc[3][4];
#pragma unroll
    for (int r = 0; r < 3; ++r)
#pragma unroll
        for (int j = 0; j < 4; ++j) acc[r][j] = 0.f;
    const float* wp = ada_w + ((size_t)layer * DM + 256 * w + ko) * (6 * DM) + col0 + 4 * cq;
#pragma unroll 8
    for (int it = 0; it < 64; ++it) { const int k = 256 * w + 4 * it + ko;
        const f32x4 wv = *(const f32x4*)(wp + (size_t)it * 4 * (6 * DM)); const f32x4 sv = *(const f32x4*)(sl + k * 4);
#pragma unroll
        for (int r = 0; r < 3; ++r)
#pragma unroll
            for (int j = 0; j < 4; ++j) acc[r][j] += sv[r] * wv[j]; }
#pragma unroll
    for (int r = 0; r < 3; ++r)
#pragma unroll
        for (int j = 0; j < 4; ++j) { float v = acc[r][j]; v += __shfl_xor(v, 16); v += __shfl_xor(v, 32); acc[r][j] = v; }
    if (ko == 0) {
#pragma unroll
        for (int r = 0; r < 3; ++r)
#pragma unroll
            for (int j = 0; j < 4; ++j) red[(w * 16 + cq) * 12 + r * 4 + j] = acc[r][j]; }
    __syncthreads();
    if (tid < 192) { const int q = tid / 12, j = tid % 12, r = j >> 2, cc = j & 3; float s = 0.f;
#pragma unroll
        for (int ww = 0; ww < 8; ++ww) s += red[(ww * 16 + q) * 12 + j];
        const int n = col0 + 4 * q + cc; s += ada_b[(size_t)layer * 6 * DM + n];
        mod[((size_t)(layer * 3 + r) * 6 + (n >> 11)) * DM + (n & (DM - 1))] = s; }
    __syncthreads();
}
__global__ __launch_bounds__(512) void k_ada(const float* c, const float* cctx, const float* ada_w, const float* ada_b, float* mod) {
    __shared__ __attribute__((aligned(16))) float sl[DM * 4]; __shared__ float red[8 * 16 * 12];
    for (int k = threadIdx.x; k < DM; k += 512) { const float a = c[k], b = c[DM + k], cc = cctx[k];
        sl[k * 4 + 0] = a * sigmoidf_(a); sl[k * 4 + 1] = b * sigmoidf_(b); sl[k * 4 + 2] = cc * sigmoidf_(cc); sl[k * 4 + 3] = 0.f; }
    __syncthreads();
    for (int u = blockIdx.x; u < 768; u += gridDim.x) ada_unit(u, c, cctx, ada_w, ada_b, mod, sl, red);
}
__global__ void k_misc(float* rope, const float* lam_re, const float* lam_im, const float* log_dt, const float* b_re, const float* b_im, float* lamb, float* bbar) {
    const int gid = blockIdx.x * blockDim.x + threadIdx.x, nth = gridDim.x * blockDim.x;
    for (int i = gid; i < SEQ * 32; i += nth) { const int l = i >> 5, axis = (i >> 4) & 1, f = i & 15;
        const float inv = (float)exp2(-(double)f / 16.0 * 13.287712379549449);
        const float pos = (float)(axis == 0 ? (l >> 6) : (l & 63)); const float ang = pos * inv;
        double s, c; sincos_d((double)ang, s, c); rope[(size_t)i * 2] = (float)c; rope[(size_t)i * 2 + 1] = (float)s; }
    for (int i = gid; i < 2 * 2 * NG * NP; i += nth) { const int jdg = i >> 6;
        const double dt = exp((double)log_dt[jdg]); const double lr = lam_re[i], li = lam_im[i];
        const double mag = exp(lr * dt); double sn, cs; sincos_d(li * dt, sn, cs);
        const double lbr = mag * cs, lbi = mag * sn, nr = lbr - 1.0, den = lr * lr + li * li;
        const double fr = (nr * lr + lbi * li) / den, fi = (lbi * lr - nr * li) / den;
        lamb[(size_t)i * 2] = (float)lbr; lamb[(size_t)i * 2 + 1] = (float)lbi;
        for (int cc = 0; cc < GC; ++cc) { const double br = b_re[(size_t)i * GC + cc], bi = b_im[(size_t)i * GC + cc];
            bbar[((size_t)i * GC + cc) * 2] = (float)(fr * br - fi * bi); bbar[((size_t)i * GC + cc) * 2 + 1] = (float)(fr * bi + fi * br); } }
}

__global__ __launch_bounds__(512) void k_norm_mod(const float* xs, const float* gnorm, const float* sh, const float* sc, bf16_t* out, int M) {
    const int lane = threadIdx.x & 63, wv = blockIdx.x * 8 + (threadIdx.x >> 6), nw = gridDim.x * 8;
    for (int row = wv; row < M; row += nw) {
        const float* xp = xs + (size_t)row * DM; f32x4 x[8]; float ss = 0.f;
#pragma unroll
        for (int i = 0; i < 8; ++i) { x[i] = *(const f32x4*)(xp + i * 256 + lane * 4); ss += x[i][0] * x[i][0] + x[i][1] * x[i][1] + x[i][2] * x[i][2] + x[i][3] * x[i][3]; }
        ss = wave_sum(ss); const float rs = rsqrtf(ss * (1.0f / DM) + EPS); const int r = modrow(row);
#pragma unroll
        for (int i = 0; i < 8; ++i) { const int col = i * 256 + lane * 4; const f32x4 g = *(const f32x4*)(gnorm + col), a = *(const f32x4*)(sc + r * 6 * DM + col), b = *(const f32x4*)(sh + r * 6 * DM + col);
            f32x4 y = x[i] * rs * g; y = y * (1.0f + a) + b;
            u32x2 w; w.x = pk2(y[0], y[1]); w.y = pk2(y[2], y[3]); *(u32x2*)(out + (size_t)row * DM + col) = w; }
    }
}
__global__ __launch_bounds__(512) void k_final_norm(const float* xs, const float* g, float* out) {
    const int lane = threadIdx.x & 63, wv = blockIdx.x * 8 + (threadIdx.x >> 6), nw = gridDim.x * 8;
    for (int row = wv; row < NLAT; row += nw) {
        const float* xp = xs + (size_t)row * DM; f32x4 x[8]; float ss = 0.f;
#pragma unroll
        for (int i = 0; i < 8; ++i) { x[i] = *(const f32x4*)(xp + i * 256 + lane * 4); ss += x[i][0] * x[i][0] + x[i][1] * x[i][1] + x[i][2] * x[i][2] + x[i][3] * x[i][3]; }
        ss = wave_sum(ss); const float rs = rsqrtf(ss * (1.0f / DM) + EPS);
#pragma unroll
        for (int i = 0; i < 8; ++i) { const int col = i * 256 + lane * 4; *(f32x4*)(out + (size_t)row * DM + col) = x[i] * rs * *(const f32x4*)(g + col); }
    }
}
__global__ __launch_bounds__(512) void k_mla_mid(const float* qc, const float* qnorm, const float* kvnorm, const float* rope, bf16_t* qn, bf16_t* ckvn, bf16_t* kpe, int M) {
    const int lane = threadIdx.x & 63, wv = blockIdx.x * 8 + (threadIdx.x >> 6), nw = gridDim.x * 8;
    for (int row = wv; row < M; row += nw) {
        const float* p = qc + (size_t)row * NDQKV;
#pragma unroll
        for (int part = 0; part < 2; ++part) {
            const f32x4 a = *(const f32x4*)(p + part * 512 + lane * 8), b = *(const f32x4*)(p + part * 512 + lane * 8 + 4);
            float ss = a[0] * a[0] + a[1] * a[1] + a[2] * a[2] + a[3] * a[3] + b[0] * b[0] + b[1] * b[1] + b[2] * b[2] + b[3] * b[3];
            ss = wave_sum(ss); const float rs = rsqrtf(ss * (1.0f / 512) + EPS);
            const float* gn = (part ? kvnorm : qnorm) + lane * 8; const f32x4 g0 = *(const f32x4*)gn, g1 = *(const f32x4*)(gn + 4);
            const f32x4 y0 = a * rs * g0, y1 = b * rs * g1;
            u32x4 w; w.x = pk2(y0[0], y0[1]); w.y = pk2(y0[2], y0[3]); w.z = pk2(y1[0], y1[1]); w.w = pk2(y1[2], y1[3]);
            *(u32x4*)((part ? ckvn : qn) + (size_t)row * 512 + lane * 8) = w; }
        int bb, key, lpos; row_bk(row, bb, key, lpos);
        float v = p[1024 + lane]; const float other = __shfl_xor(v, 1);
        if (lpos >= 0) { const int axis = lane >> 5, f = (lane & 31) >> 1; const float cs = rope[((size_t)(lpos * 2 + axis) * 16 + f) * 2], sn = rope[((size_t)(lpos * 2 + axis) * 16 + f) * 2 + 1];
            v = (lane & 1) ? (other * sn + v * cs) : (v * cs - other * sn); }
        kpe[((size_t)bb * NKEY + key) * DR + lane] = f2bf(v);
    }
}

__global__ __launch_bounds__(128) void k_s5_naive(const bf16_t* abuf, const float* lamb, const float* bbar, const float* c_re, const float* c_im, int j, float* yf, float* yb) {
    extern __shared__ __attribute__((aligned(16))) unsigned char shm[];
    bf16_t* us = (bf16_t*)shm;
    float* hs = (float*)(shm + NKEY * 32);
    float* cs = hs + 256;
    const int g = blockIdx.x, b = blockIdx.y, tid = threadIdx.x, dir = tid >> 6, p = tid & 63;
    for (int i = tid; i < NKEY * 2; i += 128) { const int t = i >> 1, hf = i & 1; const int row = t < SEQ ? b * SEQ + t : NLAT + b * CTX + (t - SEQ);
        *(u32x4*)(us + t * 16 + hf * 8) = *(const u32x4*)(abuf + (size_t)row * DM + g * 16 + hf * 8); }
    for (int i = tid; i < 2 * 16 * 64; i += 128) { const int d = i >> 10, r = i & 1023; cs[(d * 2 + 0) * 1024 + r] = c_re[((size_t)(j * 2 + d) * NG + g) * 1024 + r]; cs[(d * 2 + 1) * 1024 + r] = c_im[((size_t)(j * 2 + d) * NG + g) * 1024 + r]; }
    const size_t sidx = ((size_t)(j * 2 + dir) * NG + g) * NP + p;
    const float ar = lamb[sidx * 2], ai = lamb[sidx * 2 + 1];
    float br[16], bi[16];
#pragma unroll
    for (int c = 0; c < 16; ++c) { br[c] = bbar[(sidx * 16 + c) * 2]; bi[c] = bbar[(sidx * 16 + c) * 2 + 1]; }
    float hr = 0.f, hi = 0.f;
    __syncthreads();
    for (int tau = 0; tau < NKEY; ++tau) {
        int t;
        if (dir == 0) t = tau < CTX ? SEQ + tau : tau - CTX; else t = tau < CTX ? SEQ + (CTX - 1 - tau) : (SEQ - 1) - (tau - CTX);
        const u32x4 u0 = *(const u32x4*)(us + t * 16), u1 = *(const u32x4*)(us + t * 16 + 8);
        float u[16];
        u[0] = __uint_as_float(u0.x << 16); u[1] = __uint_as_float(u0.x & 0xffff0000u); u[2] = __uint_as_float(u0.y << 16); u[3] = __uint_as_float(u0.y & 0xffff0000u);
        u[4] = __uint_as_float(u0.z << 16); u[5] = __uint_as_float(u0.z & 0xffff0000u); u[6] = __uint_as_float(u0.w << 16); u[7] = __uint_as_float(u0.w & 0xffff0000u);
        u[8] = __uint_as_float(u1.x << 16); u[9] = __uint_as_float(u1.x & 0xffff0000u); u[10] = __uint_as_float(u1.y << 16); u[11] = __uint_as_float(u1.y & 0xffff0000u);
        u[12] = __uint_as_float(u1.z << 16); u[13] = __uint_as_float(u1.z & 0xffff0000u); u[14] = __uint_as_float(u1.w << 16); u[15] = __uint_as_float(u1.w & 0xffff0000u);
        float vr = 0.f, vi = 0.f;
#pragma unroll
        for (int c = 0; c < 16; ++c) { vr += br[c] * u[c]; vi += bi[c] * u[c]; }
        const float nr = ar * hr - ai * hi + vr, ni = ar * hi + ai * hr + vi; hr = nr; hi = ni;
        hs[(dir * 2 + 0) * 64 + p] = hr; hs[(dir * 2 + 1) * 64 + p] = hi;
        __syncthreads();
        if (p < 16) { float y = 0.f; const float* cr = cs + (dir * 2 + 0) * 1024 + p * 64; const float* ci = cs + (dir * 2 + 1) * 1024 + p * 64; const float* h_r = hs + (dir * 2 + 0) * 64; const float* h_i = hs + (dir * 2 + 1) * 64;
#pragma unroll 16
            for (int q = 0; q < 64; ++q) y += cr[q] * h_r[q] - ci[q] * h_i[q];
            const int row = t < SEQ ? b * SEQ + t : NLAT + b * CTX + (t - SEQ);
            (dir ? yb : yf)[(size_t)row * DM + g * 16 + p] = y; }
        __syncthreads();
    }
}
__global__ __launch_bounds__(256) void k_s5_z(const bf16_t* abuf, const float* dsk, const float* yf, const float* yb, bf16_t* z, size_t n4) {
    for (size_t i = (size_t)blockIdx.x * 256 + threadIdx.x; i < n4; i += (size_t)gridDim.x * 256) {
        const int col = (int)((i * 4) & (DM - 1)); const u32x2 uu = *(const u32x2*)(abuf + i * 4); const f32x4 a = *(const f32x4*)(yf + i * 4), b = *(const f32x4*)(yb + i * 4), d = *(const f32x4*)(dsk + col);
        const float u0 = __uint_as_float(uu.x << 16), u1 = __uint_as_float(uu.x & 0xffff0000u), u2 = __uint_as_float(uu.y << 16), u3 = __uint_as_float(uu.y & 0xffff0000u);
        u32x2 w; w.x = pk2(gelu_tanh(d[0] * u0 + a[0] + b[0]), gelu_tanh(d[1] * u1 + a[1] + b[1])); w.y = pk2(gelu_tanh(d[2] * u2 + a[2] + b[2]), gelu_tanh(d[3] * u3 + a[3] + b[3]));
        *(u32x2*)(z + i * 4) = w; }
}

__global__ __launch_bounds__(256) void k_attn_naive(const bf16_t* Q, const bf16_t* K, const bf16_t* Kpe, const bf16_t* V, bf16_t* out, int q0, int nk, int rowbase_b_stride, int rowbase0) {
    const int tid = threadIdx.x, ql = tid >> 2, sub = tid & 3, h = blockIdx.y, b = blockIdx.z, qi = q0 + blockIdx.x * 64 + ql;
    const bf16_t* qp = Q + ((size_t)(b * NH + h) * NKEY + qi) * DQK + 48 * sub;
    float q[48];
#pragma unroll
    for (int c = 0; c < 6; ++c) { const u32x4 w = *(const u32x4*)(qp + c * 8);
        q[c * 8 + 0] = __uint_as_float(w.x << 16); q[c * 8 + 1] = __uint_as_float(w.x & 0xffff0000u); q[c * 8 + 2] = __uint_as_float(w.y << 16); q[c * 8 + 3] = __uint_as_float(w.y & 0xffff0000u);
        q[c * 8 + 4] = __uint_as_float(w.z << 16); q[c * 8 + 5] = __uint_as_float(w.z & 0xffff0000u); q[c * 8 + 6] = __uint_as_float(w.w << 16); q[c * 8 + 7] = __uint_as_float(w.w & 0xffff0000u); }
    float o[32];
#pragma unroll
    for (int i = 0; i < 32; ++i) o[i] = 0.f;
    float m = -1e30f, l = 0.f;
    const bf16_t* Kh = K + (size_t)(b * NH + h) * NKEY * DN; const bf16_t* Vh = V + (size_t)(b * NH + h) * NKEY * DV; const bf16_t* Pb = Kpe + (size_t)b * NKEY * DR;
    for (int key = 0; key < nk; ++key) {
        float s = 0.f;
#pragma unroll
        for (int c = 0; c < 6; ++c) { const int d0 = 48 * sub + 8 * c;
            const bf16_t* kp = d0 < DN ? Kh + (size_t)key * DN + d0 : Pb + (size_t)key * DR + (d0 - DN);
            const u32x4 w = *(const u32x4*)kp;
            s += q[c * 8 + 0] * __uint_as_float(w.x << 16) + q[c * 8 + 1] * __uint_as_float(w.x & 0xffff0000u) + q[c * 8 + 2] * __uint_as_float(w.y << 16) + q[c * 8 + 3] * __uint_as_float(w.y & 0xffff0000u)
               + q[c * 8 + 4] * __uint_as_float(w.z << 16) + q[c * 8 + 5] * __uint_as_float(w.z & 0xffff0000u) + q[c * 8 + 6] * __uint_as_float(w.w << 16) + q[c * 8 + 7] * __uint_as_float(w.w & 0xffff0000u); }
        s += __shfl_xor(s, 1); s += __shfl_xor(s, 2);
        const float mn = fmaxf(m, s), alpha = exp2f(m - mn), pr = exp2f(s - mn); m = mn; l = l * alpha + pr;
        const bf16_t* vp = Vh + (size_t)key * DV + 32 * sub;
#pragma unroll
        for (int c = 0; c < 4; ++c) { const u32x4 w = *(const u32x4*)(vp + c * 8);
            o[c * 8 + 0] = o[c * 8 + 0] * alpha + pr * __uint_as_float(w.x << 16); o[c * 8 + 1] = o[c * 8 + 1] * alpha + pr * __uint_as_float(w.x & 0xffff0000u);
            o[c * 8 + 2] = o[c * 8 + 2] * alpha + pr * __uint_as_float(w.y << 16); o[c * 8 + 3] = o[c * 8 + 3] * alpha + pr * __uint_as_float(w.y & 0xffff0000u);
            o[c * 8 + 4] = o[c * 8 + 4] * alpha + pr * __uint_as_float(w.z << 16); o[c * 8 + 5] = o[c * 8 + 5] * alpha + pr * __uint_as_float(w.z & 0xffff0000u);
            o[c * 8 + 6] = o[c * 8 + 6] * alpha + pr * __uint_as_float(w.w << 16); o[c * 8 + 7] = o[c * 8 + 7] * alpha + pr * __uint_as_float(w.w & 0xffff0000u); }
    }
    const float il = 1.0f / l;
    const int row = rowbase0 + b * rowbase_b_stride + (qi - q0);
    bf16_t* op = out + (size_t)row * DM + h * DV + 32 * sub;
#pragma unroll
    for (int c = 0; c < 4; ++c) { u32x4 w; w.x = pk2(o[c * 8] * il, o[c * 8 + 1] * il); w.y = pk2(o[c * 8 + 2] * il, o[c * 8 + 3] * il); w.z = pk2(o[c * 8 + 4] * il, o[c * 8 + 5] * il); w.w = pk2(o[c * 8 + 6] * il, o[c * 8 + 7] * il);
        *(u32x4*)(op + c * 8) = w; }
}

template <class Epi> static void launch_gemm(hipStream_t s, const bf16_t* A, const bf16_t* Bt, int M, int N, int K, const Epi& E) {
    static bool attr = false;
    if (!attr) { (void)hipFuncSetAttribute((const void*)k_gemm<Epi>, hipFuncAttributeMaxDynamicSharedMemorySize, pg8::STAGE_BYTES); attr = true; }
    pg8::Gemm g; memset(&g, 0, sizeof(g)); g.A = A; g.Bt = Bt; g.M = M; g.N = N; g.K = K;
    hipLaunchKernelGGL(k_gemm<Epi>, dim3(256), dim3(512), pg8::STAGE_BYTES, s, g, E);
}
template <class T> static T zeroed() { T t; memset(&t, 0, sizeof(T)); return t; }
static void launch_cvt(hipStream_t s, const float* s0, int ld0, const float* s1, int ld1, int K, int Nrows, int mode, bf16_t* dst) {
    CvtDesc d = zeroed<CvtDesc>(); d.src0 = s0; d.src1 = s1; d.ld0 = ld0; d.ld1 = ld1; d.K = K; d.mode = mode; d.dst = dst;
    hipLaunchKernelGGL(k_cvt, dim3(K / 64, Nrows / 64), dim3(256), 0, s, d);
}

extern "C" void kernel_launch(void* const* d_in, const int* in_sizes, int n_in, void* d_out, int out_size, void* d_ws, size_t ws_size, hipStream_t stream) {
    if (n_in != 28 || ws_size < WS_END) { fprintf(stderr, "kernel_launch: unexpected inputs (%d) or workspace (%zu < %zu)\n", n_in, ws_size, (size_t)WS_END); return; }
    const float* x = (const float*)d_in[0]; const float* c = (const float*)d_in[1]; const float* ctx = (const float*)d_in[2]; const float* cctx = (const float*)d_in[3];
    const float* ada_w = (const float*)d_in[4]; const float* ada_b = (const float*)d_in[5]; const float* norm1_g = (const float*)d_in[6]; const float* norm2_g = (const float*)d_in[7];
    const float* final_g = (const float*)d_in[8]; const float* lam_re = (const float*)d_in[9]; const float* lam_im = (const float*)d_in[10]; const float* log_dt = (const float*)d_in[11];
    const float* b_re = (const float*)d_in[12]; const float* b_im = (const float*)d_in[13]; const float* c_re = (const float*)d_in[14]; const float* c_im = (const float*)d_in[15];
    const float* s5_d = (const float*)d_in[16]; const float* w_glu = (const float*)d_in[17]; const float* b_glu = (const float*)d_in[18];
    const float* w_dq = (const float*)d_in[19]; const float* q_norm = (const float*)d_in[20]; const float* w_uq = (const float*)d_in[21]; const float* w_dkv = (const float*)d_in[22];
    const float* kv_norm = (const float*)d_in[23]; const float* w_ukv = (const float*)d_in[24]; const float* w_o = (const float*)d_in[25]; const float* ffn_w1 = (const float*)d_in[26]; const float* ffn_w2 = (const float*)d_in[27];
    char* ws = (char*)d_ws;
    float* mod = (float*)(ws + OFF_MOD); float* rope = (float*)(ws + OFF_ROPE); float* lamb = (float*)(ws + OFF_LAMB); float* bbar = (float*)(ws + OFF_BBAR);
    float* xs = (float*)(ws + OFF_XS); bf16_t* abuf = (bf16_t*)(ws + OFF_ABUF); bf16_t* zbuf = (bf16_t*)(ws + OFF_ZBUF); bf16_t* hbuf = (bf16_t*)(ws + OFF_HBUF);
    float* yf = (float*)(ws + OFF_YF); float* yb = (float*)(ws + OFF_YB); float* qc = (float*)(ws + OFF_QC); bf16_t* qn = (bf16_t*)(ws + OFF_QN); bf16_t* ckvn = (bf16_t*)(ws + OFF_CKVN);
    bf16_t* kpe = (bf16_t*)(ws + OFF_KPE); bf16_t* Qb = (bf16_t*)(ws + OFF_Q); bf16_t* Kb = (bf16_t*)(ws + OFF_K); bf16_t* Vb = (bf16_t*)(ws + OFF_V);
    bf16_t* w1t = (bf16_t*)(ws + OFF_W1T); bf16_t* w2t = (bf16_t*)(ws + OFF_W2T); bf16_t* wglut = (bf16_t*)(ws + OFF_WGLUT); bf16_t* wot = (bf16_t*)(ws + OFF_WOT);
    bf16_t* wdqkvt = (bf16_t*)(ws + OFF_WDQKVT); bf16_t* wuqt = (bf16_t*)(ws + OFF_WUQT); bf16_t* wukvt = (bf16_t*)(ws + OFF_WUKVT);

    (void)hipMemcpyAsync(xs, x, (size_t)NLAT * DM * 4, hipMemcpyDeviceToDevice, stream);
    (void)hipMemcpyAsync(xs + (size_t)NLAT * DM, ctx, (size_t)NCTX * DM * 4, hipMemcpyDeviceToDevice, stream);
    for (int i = 0; i < DEPTH; ++i) {
        launch_cvt(stream, ffn_w1 + (size_t)i * DM * DFF, DFF, nullptr, 0, DM, DFF, 0, w1t + (size_t)i * DFF * DM);
        launch_cvt(stream, ffn_w2 + (size_t)i * DFF * DM, DM, nullptr, 0, DFF, DM, 0, w2t + (size_t)i * DM * DFF);
    }
    for (int j = 0; j < 2; ++j) {
        launch_cvt(stream, w_glu + (size_t)j * DM * DM, DM, nullptr, 0, DM, DM, 0, wglut + (size_t)j * DM * DM);
        launch_cvt(stream, w_o + (size_t)j * DM * DM, DM, nullptr, 0, DM, DM, 0, wot + (size_t)j * DM * DM);
        launch_cvt(stream, w_dq + (size_t)j * DM * QL, QL, w_dkv + (size_t)j * DM * (KVL + DR), KVL + DR, DM, NDQKV, 1, wdqkvt + (size_t)j * NDQKV * DM);
        launch_cvt(stream, w_uq + (size_t)j * QL * NH * DQK, NH * DQK, nullptr, 0, QL, NH * DQK, 2, wuqt + (size_t)j * NH * DQK * QL);
        launch_cvt(stream, w_ukv + (size_t)j * KVL * NH * (DN + DV), NH * (DN + DV), nullptr, 0, KVL, NH * (DN + DV), 0, wukvt + (size_t)j * NH * (DN + DV) * KVL);
    }
    hipLaunchKernelGGL(k_ada, dim3(256), dim3(512), 0, stream, c, cctx, ada_w, ada_b, mod);
    hipLaunchKernelGGL(k_misc, dim3(256), dim3(256), 0, stream, rope, lam_re, lam_im, log_dt, b_re, b_im, lamb, bbar);

    static bool attr = false;
    if (!attr) { (void)hipFuncSetAttribute((const void*)k_s5_naive, hipFuncAttributeMaxDynamicSharedMemorySize, NKEY * 32 + 256 * 4 + 4096 * 4); attr = true; }
    const float qscale = 0.07216878364870322f * 1.4426950408889634f;

    for (int i = 0; i < DEPTH; ++i) {
        const bool last = (i == DEPTH - 1); const int j = i >> 1; const int M = last ? NLAT : MROWS;
        const float* modl = mod + (size_t)i * 3 * 6 * DM;
        hipLaunchKernelGGL(k_norm_mod, dim3(256), dim3(512), 0, stream, xs, norm1_g + (size_t)i * DM, modl + 0 * DM, modl + 1 * DM, abuf, MROWS);
        if ((i & 1) == 0) {
            hipLaunchKernelGGL(k_s5_naive, dim3(NG, NB), dim3(128), NKEY * 32 + 256 * 4 + 4096 * 4, stream, abuf, lamb, bbar, c_re, c_im, j, yf, yb);
            hipLaunchKernelGGL(k_s5_z, dim3(2048), dim3(256), 0, stream, abuf, s5_d + (size_t)j * DM, yf, yb, zbuf, (size_t)MROWS * DM / 4);
            Epi4<FGlu> e = zeroed<Epi4<FGlu>>(); e.f.xs = xs; e.f.g = modl + 2 * DM; e.f.z = zbuf; e.f.bglu = b_glu + (size_t)j * DM;
            launch_gemm(stream, zbuf, wglut + (size_t)j * DM * DM, M, DM, DM, e);
        } else {
            { Epi4<FF32> e = zeroed<Epi4<FF32>>(); e.f.C = qc; e.f.ldc = NDQKV; launch_gemm(stream, abuf, wdqkvt + (size_t)j * NDQKV * DM, MROWS, NDQKV, DM, e); }
            hipLaunchKernelGGL(k_mla_mid, dim3(256), dim3(512), 0, stream, qc, q_norm + (size_t)j * QL, kv_norm + (size_t)j * KVL, rope, qn, ckvn, kpe, MROWS);
            { Epi8<FUq> e = zeroed<Epi8<FUq>>(); e.f.Q = Qb; e.f.rope = rope; e.f.qscale = qscale; launch_gemm(stream, qn, wuqt + (size_t)j * NH * DQK * QL, M, NH * DQK, QL, e); }
            { Epi8<FUkv> e = zeroed<Epi8<FUkv>>(); e.f.Kb = Kb; e.f.Vb = Vb; launch_gemm(stream, ckvn, wukvt + (size_t)j * NH * (DN + DV) * KVL, MROWS, NH * (DN + DV), KVL, e); }
            hipLaunchKernelGGL(k_attn_naive, dim3(SEQ / 64, NH, NB), dim3(256), 0, stream, Qb, Kb, kpe, Vb, abuf, CTX, NKEY, SEQ, 0);
            if (!last) hipLaunchKernelGGL(k_attn_naive, dim3(CTX / 64, NH, NB), dim3(256), 0, stream, Qb, Kb, kpe, Vb, abuf, 0, CTX, CTX, NLAT);
            Epi4<FRes> e = zeroed<Epi4<FRes>>(); e.f.xs = xs; e.f.g = modl + 2 * DM;
            launch_gemm(stream, abuf, wot + (size_t)j * DM * DM, M, DM, DM, e);
        }
        hipLaunchKernelGGL(k_norm_mod, dim3(256), dim3(512), 0, stream, xs, norm2_g + (size_t)i * DM, modl + 3 * DM, modl + 4 * DM, abuf, M);
        { Epi8<FUp> e = zeroed<Epi8<FUp>>(); e.f.h = hbuf; launch_gemm(stream, abuf, w1t + (size_t)i * DFF * DM, M, DFF, DM, e); }
        { Epi4<FRes> e = zeroed<Epi4<FRes>>(); e.f.xs = xs; e.f.g = modl + 5 * DM; launch_gemm(stream, hbuf, w2t + (size_t)i * DM * DFF, M, DM, DFF, e); }
    }
    hipLaunchKernelGGL(k_final_norm, dim3(256), dim3(512), 0, stream, xs, final_g, (float*)d_out);
}
```

```cpp
#include <hip/hip_runtime.h>
#include <stdint.h>
#include <cstdio>
#include <cstring>

#define LAS __attribute__((address_space(3)))
typedef unsigned short bf16_t;
typedef short bf16x8 __attribute__((ext_vector_type(8)));
typedef float f32x4 __attribute__((ext_vector_type(4)));
typedef float f32x2 __attribute__((ext_vector_type(2)));
typedef unsigned u32x4 __attribute__((ext_vector_type(4)));
typedef unsigned u32x2 __attribute__((ext_vector_type(2)));

constexpr int DM = 2048, NB = 2, SEQ = 4096, CTX = 256, DEPTH = 4, DFF = 8192;
constexpr int NLAT = NB * SEQ, NCTX = NB * CTX, MROWS = NLAT + NCTX;
constexpr int NKEY = CTX + SEQ;
constexpr int NG = 128, NP = 64, GC = 16;
constexpr int NH = 16, QL = 512, KVL = 512, DN = 128, DR = 64, DV = 128, DQK = DN + DR;
constexpr int NDQKV = 1280;
constexpr float EPS = 1e-6f;

constexpr size_t al256(size_t x) { return (x + 255) & ~(size_t)255; }
constexpr size_t OFF_BAR = 0;
constexpr size_t OFF_MOD = 16384;
constexpr size_t OFF_ROPE = OFF_MOD + al256((size_t)DEPTH * 3 * 6 * DM * 4);
constexpr size_t OFF_LAMB = OFF_ROPE + al256((size_t)SEQ * 2 * 16 * 2 * 4);
constexpr size_t OFF_BBAR = OFF_LAMB + al256((size_t)2 * 2 * NG * NP * 2 * 4);
constexpr size_t OFF_XS = OFF_BBAR + al256((size_t)2 * 2 * NG * NP * GC * 2 * 4);
constexpr size_t OFF_ABUF = OFF_XS + al256((size_t)MROWS * DM * 4);
constexpr size_t OFF_ZBUF = OFF_ABUF + al256((size_t)MROWS * DM * 2);
constexpr size_t OFF_HBUF = OFF_ZBUF + al256((size_t)MROWS * DM * 2);
constexpr size_t OFF_YF = OFF_HBUF + al256((size_t)MROWS * DFF * 2);
constexpr size_t OFF_YB = OFF_YF + al256((size_t)MROWS * DM * 4);
constexpr size_t OFF_QC = OFF_YB + al256((size_t)MROWS * DM * 4);
constexpr size_t OFF_QN = OFF_QC + al256((size_t)MROWS * NDQKV * 4);
constexpr size_t OFF_CKVN = OFF_QN + al256((size_t)MROWS * QL * 2);
constexpr size_t OFF_KPE = OFF_CKVN + al256((size_t)MROWS * KVL * 2);
constexpr size_t OFF_Q = OFF_KPE + al256((size_t)NB * NKEY * DR * 2);
constexpr size_t OFF_K = OFF_Q + al256((size_t)NB * NH * NKEY * DQK * 2);
constexpr size_t OFF_V = OFF_K + al256((size_t)NB * NH * NKEY * DN * 2);
constexpr size_t OFF_W1T = OFF_V + al256((size_t)NB * NH * NKEY * DV * 2);
constexpr size_t OFF_W2T = OFF_W1T + (size_t)DEPTH * DFF * DM * 2;
constexpr size_t OFF_WGLUT = OFF_W2T + (size_t)DEPTH * DFF * DM * 2;
constexpr size_t OFF_WOT = OFF_WGLUT + (size_t)2 * DM * DM * 2;
constexpr size_t OFF_WDQKVT = OFF_WOT + (size_t)2 * DM * DM * 2;
constexpr size_t OFF_WUQT = OFF_WDQKVT + (size_t)2 * NDQKV * DM * 2;
constexpr size_t OFF_WUKVT = OFF_WUQT + (size_t)2 * NH * DQK * QL * 2;
constexpr size_t WS_END = OFF_WUKVT + (size_t)2 * NH * (DN + DV) * KVL * 2;

__device__ __forceinline__ float bf2f(bf16_t b) { return __uint_as_float(((unsigned)b) << 16); }
__device__ __forceinline__ bf16_t f2bf(float f) { unsigned u = __float_as_uint(f); u += 0x7FFFu + ((u >> 16) & 1u); return (bf16_t)(u >> 16); }
__device__ __forceinline__ unsigned pk2(float lo, float hi) { return (unsigned)f2bf(lo) | ((unsigned)f2bf(hi) << 16); }
__device__ __forceinline__ float wave_sum(float v) {
#pragma unroll
    for (int o = 32; o >= 1; o >>= 1) v += __shfl_xor(v, o);
    return v;
}
__device__ __forceinline__ float sigmoidf_(float x) { return 1.0f / (1.0f + __expf(-x)); }
__device__ __forceinline__ float gelu_tanh(float x) { const float u = 0.7978845608028654f * (x + 0.044715f * x * x * x); return 0.5f * x * (1.0f + tanhf(u)); }
__device__ __forceinline__ void sincos_d(double a, double& s, double& c) {
    const double kd = rint(a * 0.63661977236758134308);
    double r = fma(-kd, 1.57079632679489655800e+00, a); r = fma(-kd, 6.12323399573676603587e-17, r);
    const long long k = (long long)kd; const double r2 = r * r;
    const double sp = r * (1.0 + r2 * (-1.0 / 6 + r2 * (1.0 / 120 + r2 * (-1.0 / 5040 + r2 * (1.0 / 362880 + r2 * (-1.0 / 39916800 + r2 * (1.0 / 6227020800.0)))))));
    const double cp = 1.0 + r2 * (-0.5 + r2 * (1.0 / 24 + r2 * (-1.0 / 720 + r2 * (1.0 / 40320 + r2 * (-1.0 / 3628800 + r2 * (1.0 / 479001600.0 + r2 * (-1.0 / 87178291200.0)))))));
    const int q = (int)(k & 3);
    s = (q == 0) ? sp : (q == 1) ? cp : (q == 2) ? -sp : -cp;
    c = (q == 0) ? cp : (q == 1) ? -sp : (q == 2) ? -cp : sp;
}
__device__ __forceinline__ int rope_srcd(int dp) { return (dp & 32) + (dp & 1) * 16 + ((dp & 31) >> 1); }

__device__ __forceinline__ int ltid() { int t = (int)threadIdx.x; asm volatile("" : "+v"(t)); return t; }

namespace pg8 {
constexpr int BM = 256, BK = 64, HALF = 128, HTB = HALF * BK * 2, STAGE_BYTES = 8 * HTB, NXCD = 8, WGM = 8;
__host__ __device__ __forceinline__ int lds_byte(int r, int c) { const int st = (r >> 4) * 2 + (c >> 5), rr = r & 15, cc = c & 31, ob = rr * 64 + cc * 2; return st * 1024 + (ob ^ (((ob >> 9) & 1) << 5)); }
__host__ __device__ __forceinline__ void stage_rc(int b, int& R, int& C) { const int st = b / 1024, sb = b % 1024, swz = sb ^ (((sb >> 9) & 1) << 5); R = (st >> 1) * 16 + swz / 64; C = (st & 1) * 32 + (swz % 64) / 2; }
__host__ __device__ __forceinline__ int perm32(int rho) { const int n = rho >> 4, i = rho & 15; return 8 * (i >> 2) + 4 * n + (i & 3); }
struct Unit { int pm, pn; };
struct Gemm { const bf16_t* A; const bf16_t* Bt; int M, N, K; };
struct StaticOrder {
    int nM, nN, nwg, G, c;
    __host__ __device__ void init(int M, int N, int G_, int c_) { nM = M / BM; nN = N / BM; nwg = nM * nN; G = G_; c = c_; }
    __host__ __device__ bool next(int i, Unit& u) const {
        const long L = (long)i * G + c; if (L >= nwg) return false;
        int wgid = (int)L; { const int q = nwg / NXCD, r = nwg % NXCD, xcd = wgid % NXCD, off = wgid / NXCD; wgid = (xcd < r ? xcd * (q + 1) : r * (q + 1) + (xcd - r) * q) + off; }
        const int nig = WGM * nN, gid = wgid / nig, fm = gid * WGM, gsz = (nM - fm) < WGM ? (nM - fm) : WGM;
        u.pm = fm + ((wgid % nig) % gsz); u.pn = (wgid % nig) / gsz; return true;
    }
    __device__ __forceinline__ void a_ready(const Unit&) const {}
    __device__ __forceinline__ void done(const Unit&) const {}
};
template <class Epi, class Sched>
__device__ __forceinline__ void gemm_phase(LAS unsigned char* lds, const Gemm g, const Sched& S, const Epi& E) {
    const int tid = ltid(), wid = __builtin_amdgcn_readfirstlane(tid >> 6), lane = tid & 63, wr = wid >> 2, wc = wid & 3, fr = lane & 15, fq = lane >> 4;
    const int K = g.K, nt = K / BK;
    unsigned voffA[2], voffB[2];
#pragma unroll
    for (int i = 0; i < 2; ++i) { int R, C; stage_rc(tid * 16 + i * 8192, R, C); const int Rb = Epi::PERM ? ((R & ~31) + perm32(R & 31)) : R;
        voffA[i] = (unsigned)(R * K + C) * 2u; voffB[i] = (unsigned)(Rb * K + C) * 2u; }
    const size_t kstep = (size_t)(BK * 2);
    const size_t hstep = (size_t)HALF * K * 2;
    const size_t tstep = 2 * hstep;
    const unsigned ldsw = (unsigned)wid * 1024u;
    const int aoff = lds_byte(wr * 64 + fr, fq * 8), boff = lds_byte(wc * 32 + fr, fq * 8);
#define PG8_SA(b, h) (((b) * 2 + (h)) * HTB)
#define PG8_SB(b, h) ((4 + (b) * 2 + (h)) * HTB)
#define PG8_STAGE(bufoff, gbase, voff) do { _Pragma("unroll") for (int _i = 0; _i < 2; ++_i) \
        __builtin_amdgcn_global_load_lds((const unsigned*)((const char*)(gbase) + (voff)[_i]), (LAS unsigned*)(lds + (bufoff) + ldsw + _i * 8192), 16, 0, 0); } while (0)
#define PG8_LDA(dst, b, h) do { _Pragma("unroll") for (int m = 0; m < 4; ++m) _Pragma("unroll") for (int k = 0; k < 2; ++k) dst[m][k] = *(const LAS bf16x8*)(lds + PG8_SA(b, h) + aoff + m * 2048 + k * 1024); } while (0)
#define PG8_LDB(dst, b, h) do { _Pragma("unroll") for (int n = 0; n < 2; ++n) _Pragma("unroll") for (int k = 0; k < 2; ++k) dst[n][k] = *(const LAS bf16x8*)(lds + PG8_SB(b, h) + boff + n * 2048 + k * 1024); } while (0)
#define PG8_MMA(ai, bj, At, Bt) do { __builtin_amdgcn_s_setprio(1); _Pragma("unroll") for (int m = 0; m < 4; ++m) _Pragma("unroll") for (int n = 0; n < 2; ++n) _Pragma("unroll") for (int k = 0; k < 2; ++k) \
        acc[ai][bj][m][n] = __builtin_amdgcn_mfma_f32_16x16x32_bf16(Bt[n][k], At[m][k], acc[ai][bj][m][n], 0, 0, 0); __builtin_amdgcn_s_setprio(0); } while (0)
#define PG8_WAIT_V(n) asm volatile("s_waitcnt vmcnt(" #n ")" ::: "memory")
#define PG8_WAIT_L(n) asm volatile("s_waitcnt lgkmcnt(" #n ")" ::: "memory")
#define PG8_BAR __builtin_amdgcn_s_barrier()
#define PG8_SCHED __builtin_amdgcn_sched_barrier(0)
    Unit cur, nxt; int ui = 0;
    if (!S.next(0, cur)) return;
    f32x4 acc[2][2][4][2];
#pragma unroll
    for (int a = 0; a < 2; ++a)
#pragma unroll
        for (int b = 0; b < 2; ++b)
#pragma unroll
            for (int m = 0; m < 4; ++m)
#pragma unroll
                for (int n = 0; n < 2; ++n) acc[a][b][m][n] = (f32x4){0.f, 0.f, 0.f, 0.f};
    bf16x8 At[4][2], B0[2][2], B1[2][2];
    const char* cA = (const char*)g.A + (size_t)cur.pm * tstep; const char* cB = (const char*)g.Bt + (size_t)cur.pn * tstep;
    S.a_ready(cur);
    PG8_STAGE(PG8_SB(0, 0), cB, voffB); PG8_STAGE(PG8_SA(0, 0), cA, voffA); PG8_STAGE(PG8_SB(0, 1), cB + hstep, voffB); PG8_STAGE(PG8_SA(0, 1), cA + hstep, voffA);
    if (wr == 1) PG8_BAR;
    PG8_WAIT_V(4); PG8_BAR;
    PG8_STAGE(PG8_SB(1, 0), cB + kstep, voffB); PG8_STAGE(PG8_SA(1, 0), cA + kstep, voffA); PG8_STAGE(PG8_SB(1, 1), cB + hstep + kstep, voffB);
    PG8_WAIT_V(6); PG8_BAR;
    for (;;) {
        const bool has_next = S.next(ui + 1, nxt);
        const char* nA = has_next ? (const char*)g.A + (size_t)nxt.pm * tstep : cA; const char* nB = has_next ? (const char*)g.Bt + (size_t)nxt.pn * tstep : cB;
        for (int t = 0; t < nt; t += 2) {
            const bool last = (t == nt - 2);
            const char* a1 = cA + (size_t)(t + 1) * kstep;
            const char* a2 = last ? nA : cA + (size_t)(t + 2) * kstep; const char* b2 = last ? nB : cB + (size_t)(t + 2) * kstep;
            const char* a3 = a2 + kstep; const char* b3 = b2 + kstep;
            if (last && has_next) S.a_ready(nxt);
            PG8_LDB(B0, 0, 0); PG8_SCHED; PG8_LDA(At, 0, 0); PG8_STAGE(PG8_SA(1, 1), a1 + hstep, voffA);
            PG8_WAIT_L(8); PG8_BAR; PG8_WAIT_L(0); PG8_MMA(0, 0, At, B0); PG8_BAR; PG8_SCHED;
            PG8_LDB(B1, 0, 1); PG8_STAGE(PG8_SB(0, 0), b2, voffB);
            PG8_BAR; PG8_WAIT_L(0); PG8_MMA(0, 1, At, B1); PG8_BAR;
            PG8_LDA(At, 0, 1); PG8_STAGE(PG8_SA(0, 0), a2, voffA);
            PG8_BAR; PG8_WAIT_L(0); PG8_MMA(1, 0, At, B0); PG8_BAR; PG8_SCHED;
            PG8_STAGE(PG8_SB(0, 1), b2 + hstep, voffB);
            PG8_WAIT_V(6); PG8_BAR; PG8_MMA(1, 1, At, B1); PG8_BAR;
            PG8_LDB(B0, 1, 0); PG8_SCHED; PG8_LDA(At, 1, 0); PG8_STAGE(PG8_SA(0, 1), a2 + hstep, voffA);
            PG8_WAIT_L(8); PG8_BAR; PG8_WAIT_L(0); PG8_MMA(0, 0, At, B0); PG8_BAR; PG8_SCHED;
            PG8_LDB(B1, 1, 1); PG8_STAGE(PG8_SB(1, 0), b3, voffB);
            PG8_BAR; PG8_WAIT_L(0); PG8_MMA(0, 1, At, B1); PG8_BAR;
            PG8_LDA(At, 1, 1); PG8_STAGE(PG8_SA(1, 0), a3, voffA);
            PG8_BAR; PG8_WAIT_L(0); PG8_MMA(1, 0, At, B0); PG8_BAR; PG8_SCHED;
            PG8_STAGE(PG8_SB(1, 1), b3 + hstep, voffB);
            PG8_WAIT_V(6); PG8_BAR; PG8_MMA(1, 1, At, B1); PG8_BAR;
        }
        E(acc, cur, wr, wc, fr, fq); S.done(cur);
        if (!has_next) break;
#pragma unroll
        for (int a = 0; a < 2; ++a)
#pragma unroll
            for (int b = 0; b < 2; ++b)
#pragma unroll
                for (int m = 0; m < 4; ++m)
#pragma unroll
                    for (int n = 0; n < 2; ++n) acc[a][b][m][n] = (f32x4){0.f, 0.f, 0.f, 0.f};
        cur = nxt; cA = nA; cB = nB; ++ui;
    }
    PG8_WAIT_V(0);
    if (wr == 0) PG8_BAR;
    PG8_BAR;
#undef PG8_SA
#undef PG8_SB
#undef PG8_STAGE
#undef PG8_LDA
#undef PG8_LDB
#undef PG8_MMA
#undef PG8_WAIT_V
#undef PG8_WAIT_L
#undef PG8_BAR
#undef PG8_SCHED
}
}

template <class F> struct Epi4 {
    static constexpr bool PERM = false, AFTER_DRAIN = false; F f;
    __device__ __forceinline__ void operator()(const f32x4 (&acc)[2][2][4][2], const pg8::Unit& u, int wr, int wc, int fr, int fq) const {
#pragma unroll
        for (int ai = 0; ai < 2; ++ai)
#pragma unroll
            for (int m = 0; m < 4; ++m) { const int row = u.pm * 256 + ai * 128 + wr * 64 + m * 16 + fr;
#pragma unroll
                for (int bj = 0; bj < 2; ++bj)
#pragma unroll
                    for (int n = 0; n < 2; ++n) f(row, u.pn * 256 + bj * 128 + wc * 32 + n * 16 + 4 * fq, acc[ai][bj][m][n]); }
    }
};
template <class F> struct Epi8 {
    static constexpr bool PERM = true, AFTER_DRAIN = false; F f;
    __device__ __forceinline__ void operator()(const f32x4 (&acc)[2][2][4][2], const pg8::Unit& u, int wr, int wc, int fr, int fq) const {
#pragma unroll
        for (int ai = 0; ai < 2; ++ai)
#pragma unroll
            for (int m = 0; m < 4; ++m) { const int row = u.pm * 256 + ai * 128 + wr * 64 + m * 16 + fr;
#pragma unroll
                for (int bj = 0; bj < 2; ++bj) f(row, u.pn * 256 + bj * 128 + wc * 32 + 8 * fq, acc[ai][bj][m][0], acc[ai][bj][m][1]); }
    }
};
__device__ __forceinline__ int modrow(int row) { return row < NLAT ? (row >> 12) : 2; }
struct FRes { float* xs; const float* g;
    __device__ __forceinline__ void operator()(int row, int col, f32x4 v) const {
        float* p = xs + (size_t)row * DM + col; const f32x4 gg = *(const f32x4*)(g + modrow(row) * 6 * DM + col);
        f32x4 x = *(const f32x4*)p; x += gg * v; *(f32x4*)p = x; } };
struct FGlu { float* xs; const float* g; const bf16_t* z; const float* bglu;
    __device__ __forceinline__ void operator()(int row, int col, f32x4 v) const {
        float* p = xs + (size_t)row * DM + col; const f32x4 gg = *(const f32x4*)(g + modrow(row) * 6 * DM + col); const f32x4 bb = *(const f32x4*)(bglu + col);
        const u32x2 zz = *(const u32x2*)(z + (size_t)row * DM + col);
        const float z0 = __uint_as_float(zz.x << 16), z1 = __uint_as_float(zz.x & 0xffff0000u), z2 = __uint_as_float(zz.y << 16), z3 = __uint_as_float(zz.y & 0xffff0000u);
        f32x4 x = *(const f32x4*)p;
        x[0] += gg[0] * z0 * sigmoidf_(v[0] + bb[0]); x[1] += gg[1] * z1 * sigmoidf_(v[1] + bb[1]);
        x[2] += gg[2] * z2 * sigmoidf_(v[2] + bb[2]); x[3] += gg[3] * z3 * sigmoidf_(v[3] + bb[3]);
        *(f32x4*)p = x; } };
struct FUp { bf16_t* h;
    __device__ __forceinline__ void operator()(int row, int col, f32x4 a, f32x4 b) const {
        f32x4 r0 = __builtin_elementwise_max(a, (f32x4){0.f, 0.f, 0.f, 0.f}), r1 = __builtin_elementwise_max(b, (f32x4){0.f, 0.f, 0.f, 0.f}); r0 *= r0; r1 *= r1;
        u32x4 w; w.x = pk2(r0[0], r0[1]); w.y = pk2(r0[2], r0[3]); w.z = pk2(r1[0], r1[1]); w.w = pk2(r1[2], r1[3]);
        *(u32x4*)(h + (size_t)row * DFF + col) = w; } };
struct FF32 { float* C; int ldc;
    __device__ __forceinline__ void operator()(int row, int col, f32x4 v) const { *(f32x4*)(C + (size_t)row * ldc + col) = v; } };
__device__ __forceinline__ void row_bk(int row, int& b, int& key, int& lpos) {
    if (row < NLAT) { b = row >> 12; lpos = row & (SEQ - 1); key = CTX + lpos; } else { const int r = row - NLAT; b = r >> 8; key = r & (CTX - 1); lpos = -1; } }
struct FUq { bf16_t* Q; const float* rope; float qscale;
    __device__ __forceinline__ void operator()(int row, int col, f32x4 a, f32x4 b) const {
        int bb, key, lpos; row_bk(row, bb, key, lpos);
        const int h = col / DQK, e = col - h * DQK;
        if (e >= DN && lpos >= 0) { const int ep = e - DN, axis = ep >> 5, f0 = (ep & 31) >> 1;
            const f32x4 cs0 = *(const f32x4*)(rope + ((size_t)(lpos * 2 + axis) * 16 + f0) * 2), cs1 = *(const f32x4*)(rope + ((size_t)(lpos * 2 + axis) * 16 + f0 + 2) * 2);
            f32x4 na, nb;
            na[0] = a[0] * cs0[0] - a[1] * cs0[1]; na[1] = a[0] * cs0[1] + a[1] * cs0[0]; na[2] = a[2] * cs0[2] - a[3] * cs0[3]; na[3] = a[2] * cs0[3] + a[3] * cs0[2];
            nb[0] = b[0] * cs1[0] - b[1] * cs1[1]; nb[1] = b[0] * cs1[1] + b[1] * cs1[0]; nb[2] = b[2] * cs1[2] - b[3] * cs1[3]; nb[3] = b[2] * cs1[3] + b[3] * cs1[2];
            a = na; b = nb; }
        a *= qscale; b *= qscale;
        u32x4 w; w.x = pk2(a[0], a[1]); w.y = pk2(a[2], a[3]); w.z = pk2(b[0], b[1]); w.w = pk2(b[2], b[3]);
        *(u32x4*)(Q + ((size_t)(bb * NH + h) * NKEY + key) * DQK + e) = w; } };
struct FUkv { bf16_t* Kb; bf16_t* Vb;
    __device__ __forceinline__ void operator()(int row, int col, f32x4 a, f32x4 b) const {
        int bb, key, lpos; row_bk(row, bb, key, lpos);
        const int h = col >> 8, e = col & 255;
        u32x4 w; w.x = pk2(a[0], a[1]); w.y = pk2(a[2], a[3]); w.z = pk2(b[0], b[1]); w.w = pk2(b[2], b[3]);
        bf16_t* dst = (e < DN ? Kb : Vb) + ((size_t)(bb * NH + h) * NKEY + key) * DN + (e & 127);
        *(u32x4*)dst = w; } };

#define XB_TMO      128
#define XB_XCNT(j)  (256  + 64 * (j))
#define XB_XSUB(j)  (1280 + 64 * (j))
#define XB_XGEN(j)  (2304 + 64 * (j))
#define XB_TOP      3328
#define XB_TOPGEN   3392
#define XCD_BAR_WORDS 3456
#define XB_SPIN_CAP (1u << 18)
__device__ __forceinline__ unsigned xb_ld(unsigned* p)              { return __hip_atomic_load(p, __ATOMIC_RELAXED, __HIP_MEMORY_SCOPE_AGENT); }
__device__ __forceinline__ unsigned xb_add(unsigned* p, unsigned v) { return __hip_atomic_fetch_add(p, v, __ATOMIC_RELAXED, __HIP_MEMORY_SCOPE_AGENT); }
__device__ __forceinline__ unsigned xb_xcc_id() { return (unsigned)__builtin_amdgcn_s_getreg((3 << 11) | 20) & 0xFu; }
#define XB_SPIN(cond, bar) do { unsigned _sp = 0; while (cond) { __builtin_amdgcn_s_sleep(1); \
    if ((++_sp & 255u) == 0u) { if (xb_ld(&(bar)[XB_TMO])) break; if (_sp > XB_SPIN_CAP) { atomicAdd(&(bar)[XB_TMO], 1u); break; } } } } while (0)
struct XcdBarrier { unsigned* bar; unsigned x; volatile LAS unsigned* st; };
__device__ __forceinline__ XcdBarrier xcd_barrier_post(unsigned* bar, volatile LAS unsigned* st) {
    XcdBarrier b; b.bar = bar; b.x = xb_xcc_id(); b.st = st;
    if (threadIdx.x == 0) (void)xb_add(&bar[XB_XCNT(b.x)], 1u);
    return b;
}
__device__ __forceinline__ void xcd_barrier_complete(unsigned* bar, unsigned x, unsigned& nloc, unsigned& nx) {
    const unsigned G = gridDim.x * gridDim.y * gridDim.z;
    unsigned sum, cnt, mine, sp = 0u;
    for (;;) {
        sum = 0u; cnt = 0u; mine = 0u;
#pragma unroll
        for (unsigned j = 0; j < 16; ++j) { const unsigned c = xb_ld(&bar[XB_XCNT(j)]); sum += c; cnt += (c > 0u) ? 1u : 0u; mine = (j == x) ? c : mine; }
        if (sum == G) break;
        __builtin_amdgcn_s_sleep(1);
        if ((++sp & 255u) == 0u) { if (xb_ld(&bar[XB_TMO])) break; if (sp > XB_SPIN_CAP) { atomicAdd(&bar[XB_TMO], 1u); break; } }
    }
    nloc = mine > 0u ? mine : 1u; nx = cnt > 0u ? cnt : 1u;
}
__device__ __forceinline__ void xcd_barrier(const XcdBarrier& b) {
    asm volatile("s_waitcnt vmcnt(0)" ::: "memory");
    __syncthreads();
    if (threadIdx.x == 0) {
        unsigned* bar = b.bar;
        __builtin_amdgcn_s_waitcnt(0);
        unsigned nloc = b.st[0], nx = b.st[1];
        if (nloc == 0u) { xcd_barrier_complete(bar, b.x, nloc, nx); b.st[0] = nloc; b.st[1] = nx; }
        const unsigned old = xb_add(&bar[XB_XSUB(b.x)], 1u);
        const unsigned gen = old / nloc;
        if (old + 1u == (gen + 1u) * nloc) {
            __builtin_amdgcn_fence(__ATOMIC_RELEASE, "agent");
            asm volatile("s_waitcnt vmcnt(0)" ::: "memory");
            const unsigned og = xb_add(&bar[XB_TOP], 1u);
            const unsigned tg = og / nx;
            if (og + 1u == (tg + 1u) * nx) xb_add(&bar[XB_TOPGEN], 1u);
            else XB_SPIN(xb_ld(&bar[XB_TOPGEN]) == tg, bar);
            __builtin_amdgcn_fence(__ATOMIC_ACQUIRE, "agent");
            xb_add(&bar[XB_XGEN(b.x)], 1u);
            asm volatile("s_waitcnt vmcnt(0)" ::: "memory");
        } else {
            XB_SPIN(xb_ld(&bar[XB_XGEN(b.x)]) == gen, bar);
            __builtin_amdgcn_fence(__ATOMIC_ACQUIRE, "agent");
            asm volatile("s_waitcnt vmcnt(0)" ::: "memory");
        }
    }
    __syncthreads();
}

struct P {
    const float *x, *c, *ctx, *cctx, *ada_w, *ada_b, *norm1_g, *norm2_g, *final_g, *lam_re, *lam_im, *log_dt, *b_re, *b_im, *c_re, *c_im, *s5_d, *w_glu, *b_glu;
    const float *w_dq, *q_norm, *w_uq, *w_dkv, *kv_norm, *w_ukv, *w_o, *ffn_w1, *ffn_w2;
    float* out; char* ws;
};
constexpr int LDS_BYTES = 163840;
constexpr int LDS_CTL = LDS_BYTES - 16;

__device__ __forceinline__ void cvt_tile_fast(const float* src, int ld, int K, bf16_t* dst, int k0, int n0, float* tile  ) {
    const int tid = ltid();
    f32x4 v[8];
#pragma unroll
    for (int i = 0; i < 8; ++i) { const int idx = tid + i * 512, k = idx >> 6, c4 = idx & 63; v[i] = *(const f32x4*)(src + (size_t)(k0 + k) * ld + n0 + 4 * c4); }
#pragma unroll
    for (int i = 0; i < 8; ++i) { const int idx = tid + i * 512, k = idx >> 6, c4 = idx & 63; float* t = tile + k * 257 + 4 * c4; t[0] = v[i][0]; t[1] = v[i][1]; t[2] = v[i][2]; t[3] = v[i][3]; }
    __syncthreads();
#pragma unroll
    for (int i = 0; i < 4; ++i) { const int id = tid + i * 512, n = id >> 3, kc = (id & 7) * 8; const float* t = tile + kc * 257 + n;
        u32x4 w; w.x = pk2(t[0], t[257]); w.y = pk2(t[2 * 257], t[3 * 257]); w.z = pk2(t[4 * 257], t[5 * 257]); w.w = pk2(t[6 * 257], t[7 * 257]);
        *(u32x4*)(dst + (size_t)(n0 + n) * K + k0 + kc) = w; }
    __syncthreads();
}
__device__ __forceinline__ void cvt_tile_map(const float* src0, int ld0, const float* src1, int ld1, int K, int mode, bf16_t* dst, int k0, int n0, float* tile  ) {
    const int tid = ltid();
    { const int n = n0 + (tid & 63); const float* sp = nullptr; int ld = 0;
      if (mode == 1) { if (n < 512) { sp = src0 + n; ld = ld0; } else if (n < 1024) { sp = src1 + (n - 512); ld = ld1; } else if (n < 1088) { sp = src1 + 512 + rope_srcd(n - 1024); ld = ld1; } }
      else { const int h = n / DQK, e = n - h * DQK; sp = src0 + (e < DN ? n : h * DQK + DN + rope_srcd(e - DN)); ld = ld0; }
#pragma unroll
      for (int i = 0; i < 8; ++i) { const int k = i * 8 + (tid >> 6); tile[k * 65 + (tid & 63)] = sp ? sp[(size_t)(k0 + k) * ld] : 0.f; } }
    __syncthreads();
    { const int n = tid >> 3, kc = (tid & 7) * 8; const float* t = tile + kc * 65 + n;
      u32x4 w; w.x = pk2(t[0], t[65]); w.y = pk2(t[2 * 65], t[3 * 65]); w.z = pk2(t[4 * 65], t[5 * 65]); w.w = pk2(t[6 * 65], t[7 * 65]);
      *(u32x4*)(dst + (size_t)(n0 + n) * K + k0 + kc) = w; }
    __syncthreads();
}
__device__ __forceinline__ void ada_unit(int u, const float* ada_w, const float* ada_b, float* mod, const float* sl  , float* red  ) {
    const int tid = ltid(), w = tid >> 6, l = tid & 63, cq = l & 15, ko = l >> 4;
    const int layer = u / 192, col0 = (u % 192) * 64;
    float acc[3][4];
#pragma unroll
    for (int r = 0; r < 3; ++r)
#pragma unroll
        for (int j = 0; j < 4; ++j) acc[r][j] = 0.f;
    const float* wp = ada_w + ((size_t)layer * DM + 256 * w + ko) * (6 * DM) + col0 + 4 * cq;
#pragma unroll 8
    for (int it = 0; it < 64; ++it) { const int k = 256 * w + 4 * it + ko;
        const f32x4 wv = *(const f32x4*)(wp + (size_t)it * 4 * (6 * DM)); const f32x4 sv = *(const f32x4*)(sl + k * 4);
#pragma unroll
        for (int r = 0; r < 3; ++r)
#pragma unroll
            for (int j = 0; j < 4; ++j) acc[r][j] += sv[r] * wv[j]; }
#pragma unroll
    for (int r = 0; r < 3; ++r)
#pragma unroll
        for (int j = 0; j < 4; ++j) { float v = acc[r][j]; v += __shfl_xor(v, 16); v += __shfl_xor(v, 32); acc[r][j] = v; }
    if (ko == 0) {
#pragma unroll
        for (int r = 0; r < 3; ++r)
#pragma unroll
            for (int j = 0; j < 4; ++j) red[(w * 16 + cq) * 12 + r * 4 + j] = acc[r][j]; }
    __syncthreads();
    if (tid < 192) { const int q = tid / 12, j = tid % 12, r = j >> 2, cc = j & 3; float s = 0.f;
#pragma unroll
        for (int ww = 0; ww < 8; ++ww) s += red[(ww * 16 + q) * 12 + j];
        const int n = col0 + 4 * q + cc; s += ada_b[(size_t)layer * 6 * DM + n];
        mod[((size_t)(layer * 3 + r) * 6 + (n >> 11)) * DM + (n & (DM - 1))] = s; }
    __syncthreads();
}
__device__ __forceinline__ void misc_phase(const P& p, int gid, int nth) {
    float* rope = (float*)(p.ws + OFF_ROPE); float* lamb = (float*)(p.ws + OFF_LAMB); float* bbar = (float*)(p.ws + OFF_BBAR);
    for (int i = gid; i < SEQ * 32; i += nth) { const int l = i >> 5, axis = (i >> 4) & 1, f = i & 15;
        const float inv = (float)exp2(-(double)f / 16.0 * 13.287712379549449);
        const float pos = (float)(axis == 0 ? (l >> 6) : (l & 63)); const float ang = pos * inv;
        double s, c; sincos_d((double)ang, s, c); rope[(size_t)i * 2] = (float)c; rope[(size_t)i * 2 + 1] = (float)s; }
    for (int i = gid; i < 2 * 2 * NG * NP; i += nth) { const int jdg = i >> 6;
        const double dt = exp((double)p.log_dt[jdg]); const double lr = p.lam_re[i], li = p.lam_im[i];
        const double mag = exp(lr * dt); double sn, cs; sincos_d(li * dt, sn, cs);
        const double lbr = mag * cs, lbi = mag * sn, nr = lbr - 1.0, den = lr * lr + li * li;
        const double fr = (nr * lr + lbi * li) / den, fi = (lbi * lr - nr * li) / den;
        lamb[(size_t)i * 2] = (float)lbr; lamb[(size_t)i * 2 + 1] = (float)lbi;
        for (int cc = 0; cc < GC; ++cc) { const double br = p.b_re[(size_t)i * GC + cc], bi = p.b_im[(size_t)i * GC + cc];
            bbar[((size_t)i * GC + cc) * 2] = (float)(fr * br - fi * bi); bbar[((size_t)i * GC + cc) * 2 + 1] = (float)(fr * bi + fi * br); } }
}
__device__ __forceinline__ void prologue_phase(const P& p, unsigned char* lds) {
    const int tid = ltid(), bid = blockIdx.x, G = gridDim.x;
    float* tile = (float*)lds;
    bf16_t* w1t = (bf16_t*)(p.ws + OFF_W1T); bf16_t* w2t = (bf16_t*)(p.ws + OFF_W2T); bf16_t* wglut = (bf16_t*)(p.ws + OFF_WGLUT); bf16_t* wot = (bf16_t*)(p.ws + OFF_WOT);
    bf16_t* wdqkvt = (bf16_t*)(p.ws + OFF_WDQKVT); bf16_t* wuqt = (bf16_t*)(p.ws + OFF_WUQT); bf16_t* wukvt = (bf16_t*)(p.ws + OFF_WUKVT);
    for (int t = bid; t < 9472; t += G) {
        const float* src; bf16_t* dst; int ld, K, kt, nt_;
        if (t < 4096) { const int i = t >> 10, r = t & 1023; src = p.ffn_w1 + (size_t)i * DM * DFF; dst = w1t + (size_t)i * DFF * DM; ld = DFF; K = DM; kt = r & 31; nt_ = r >> 5; }
        else if (t < 8192) { const int i = (t - 4096) >> 10, r = t & 1023; src = p.ffn_w2 + (size_t)i * DFF * DM; dst = w2t + (size_t)i * DM * DFF; ld = DM; K = DFF; kt = r & 127; nt_ = r >> 7; }
        else if (t < 8704) { const int j = (t - 8192) >> 8, r = t & 255; src = p.w_glu + (size_t)j * DM * DM; dst = wglut + (size_t)j * DM * DM; ld = DM; K = DM; kt = r & 31; nt_ = r >> 5; }
        else if (t < 9216) { const int j = (t - 8704) >> 8, r = t & 255; src = p.w_o + (size_t)j * DM * DM; dst = wot + (size_t)j * DM * DM; ld = DM; K = DM; kt = r & 31; nt_ = r >> 5; }
        else { const int j = (t - 9216) >> 7, r = t & 127; src = p.w_ukv + (size_t)j * KVL * 4096; dst = wukvt + (size_t)j * 4096 * KVL; ld = 4096; K = KVL; kt = r & 7; nt_ = r >> 3; }
        cvt_tile_fast(src, ld, K, dst, kt * 64, nt_ * 256, tile);
    }
    for (int t = bid; t < 2048; t += G) {
        if (t < 1280) { const int j = t / 640, r = t % 640, kt = r & 31, nt_ = r >> 5;
            cvt_tile_map(p.w_dq + (size_t)j * DM * QL, QL, p.w_dkv + (size_t)j * DM * (KVL + DR), KVL + DR, DM, 1, wdqkvt + (size_t)j * NDQKV * DM, kt * 64, nt_ * 64, tile); }
        else { const int tt = t - 1280, j = tt / 384, r = tt % 384, kt = r & 7, nt_ = r >> 3;
            cvt_tile_map(p.w_uq + (size_t)j * QL * NH * DQK, NH * DQK, nullptr, 0, QL, 2, wuqt + (size_t)j * NH * DQK * QL, kt * 64, nt_ * 64, tile); }
    }
    float* sl = (float*)lds; float* red = sl + DM * 4;
    for (int k = tid; k < DM; k += 512) { const float a = p.c[k], b = p.c[DM + k], cc = p.cctx[k];
        sl[k * 4 + 0] = a * sigmoidf_(a); sl[k * 4 + 1] = b * sigmoidf_(b); sl[k * 4 + 2] = cc * sigmoidf_(cc); sl[k * 4 + 3] = 0.f; }
    __syncthreads();
    for (int u = bid; u < 768; u += G) ada_unit(u, p.ada_w, p.ada_b, (float*)(p.ws + OFF_MOD), sl, red);
    misc_phase(p, bid * 512 + tid, G * 512);
}

__device__ __forceinline__ void norm_mod_phase(const float* xs, const float* gnorm, const float* sh, const float* sc, bf16_t* out, int M) {
    const int lane = ltid() & 63, wv = blockIdx.x * 8 + (ltid() >> 6), nw = gridDim.x * 8;
    for (int row = wv; row < M; row += nw) {
        const float* xp = xs + (size_t)row * DM; f32x4 x[8]; float ss = 0.f;
#pragma unroll
        for (int i = 0; i < 8; ++i) { x[i] = *(const f32x4*)(xp + i * 256 + lane * 4); ss += x[i][0] * x[i][0] + x[i][1] * x[i][1] + x[i][2] * x[i][2] + x[i][3] * x[i][3]; }
        ss = wave_sum(ss); const float rs = rsqrtf(ss * (1.0f / DM) + EPS); const int r = modrow(row);
#pragma unroll
        for (int i = 0; i < 8; ++i) { const int col = i * 256 + lane * 4; const f32x4 g = *(const f32x4*)(gnorm + col), a = *(const f32x4*)(sc + r * 6 * DM + col), b = *(const f32x4*)(sh + r * 6 * DM + col);
            f32x4 y = x[i] * rs * g; y = y * (1.0f + a) + b;
            u32x2 w; w.x = pk2(y[0], y[1]); w.y = pk2(y[2], y[3]); *(u32x2*)(out + (size_t)row * DM + col) = w; }
    }
}
__device__ __forceinline__ void final_norm_phase(const float* xs, const float* g, float* out) {
    const int lane = ltid() & 63, wv = blockIdx.x * 8 + (ltid() >> 6), nw = gridDim.x * 8;
    for (int row = wv; row < NLAT; row += nw) {
        const float* xp = xs + (size_t)row * DM; f32x4 x[8]; float ss = 0.f;
#pragma unroll
        for (int i = 0; i < 8; ++i) { x[i] = *(const f32x4*)(xp + i * 256 + lane * 4); ss += x[i][0] * x[i][0] + x[i][1] * x[i][1] + x[i][2] * x[i][2] + x[i][3] * x[i][3]; }
        ss = wave_sum(ss); const float rs = rsqrtf(ss * (1.0f / DM) + EPS);
#pragma unroll
        for (int i = 0; i < 8; ++i) { const int col = i * 256 + lane * 4; *(f32x4*)(out + (size_t)row * DM + col) = x[i] * rs * *(const f32x4*)(g + col); }
    }
}
__device__ __forceinline__ void mla_mid_phase(const float* qc, const float* qnorm, const float* kvnorm, const float* rope, bf16_t* qn, bf16_t* ckvn, bf16_t* kpe, int M) {
    const int lane = ltid() & 63, wv = blockIdx.x * 8 + (ltid() >> 6), nw = gridDim.x * 8;
    for (int row = wv; row < M; row += nw) {
        const float* p = qc + (size_t)row * NDQKV;
#pragma unroll
        for (int part = 0; part < 2; ++part) {
            const f32x4 a = *(const f32x4*)(p + part * 512 + lane * 8), b = *(const f32x4*)(p + part * 512 + lane * 8 + 4);
            float ss = a[0] * a[0] + a[1] * a[1] + a[2] * a[2] + a[3] * a[3] + b[0] * b[0] + b[1] * b[1] + b[2] * b[2] + b[3] * b[3];
            ss = wave_sum(ss); const float rs = rsqrtf(ss * (1.0f / 512) + EPS);
            const float* gn = (part ? kvnorm : qnorm) + lane * 8; const f32x4 g0 = *(const f32x4*)gn, g1 = *(const f32x4*)(gn + 4);
            const f32x4 y0 = a * rs * g0, y1 = b * rs * g1;
            u32x4 w; w.x = pk2(y0[0], y0[1]); w.y = pk2(y0[2], y0[3]); w.z = pk2(y1[0], y1[1]); w.w = pk2(y1[2], y1[3]);
            *(u32x4*)((part ? ckvn : qn) + (size_t)row * 512 + lane * 8) = w; }
        int bb, key, lpos; row_bk(row, bb, key, lpos);
        float v = p[1024 + lane]; const float other = __shfl_xor(v, 1);
        if (lpos >= 0) { const int axis = lane >> 5, f = (lane & 31) >> 1; const float cs = rope[((size_t)(lpos * 2 + axis) * 16 + f) * 2], sn = rope[((size_t)(lpos * 2 + axis) * 16 + f) * 2 + 1];
            v = (lane & 1) ? (other * sn + v * cs) : (v * cs - other * sn); }
        kpe[((size_t)bb * NKEY + key) * DR + lane] = f2bf(v);
    }
}

__device__ __forceinline__ void s5_naive_unit(int g, int b, const bf16_t* abuf, const float* lamb, const float* bbar, const float* c_re, const float* c_im, int j, float* yf, float* yb, unsigned char* shm) {
    bf16_t* us = (bf16_t*)shm;
    float* hs = (float*)(shm + NKEY * 32);
    float* cs = hs + 256;
    const int tid = ltid(), dir = (tid >> 6) & 1, p = tid & 63; const bool act = tid < 128;
    for (int i = tid; i < NKEY * 2; i += 512) { const int t = i >> 1, hf = i & 1; const int row = t < SEQ ? b * SEQ + t : NLAT + b * CTX + (t - SEQ);
        *(u32x4*)(us + t * 16 + hf * 8) = *(const u32x4*)(abuf + (size_t)row * DM + g * 16 + hf * 8); }
    for (int i = tid; i < 2 * 16 * 64; i += 512) { const int d = i >> 10, r = i & 1023; cs[(d * 2 + 0) * 1024 + r] = c_re[((size_t)(j * 2 + d) * NG + g) * 1024 + r]; cs[(d * 2 + 1) * 1024 + r] = c_im[((size_t)(j * 2 + d) * NG + g) * 1024 + r]; }
    const size_t sidx = ((size_t)(j * 2 + dir) * NG + g) * NP + p;
    const float ar = lamb[sidx * 2], ai = lamb[sidx * 2 + 1];
    float br[16], bi[16];
#pragma unroll
    for (int c = 0; c < 16; ++c) { br[c] = bbar[(sidx * 16 + c) * 2]; bi[c] = bbar[(sidx * 16 + c) * 2 + 1]; }
    float hr = 0.f, hi = 0.f;
    __syncthreads();
    for (int tau = 0; tau < NKEY; ++tau) {
        int t;
        if (dir == 0) t = tau < CTX ? SEQ + tau : tau - CTX; else t = tau < CTX ? SEQ + (CTX - 1 - tau) : (SEQ - 1) - (tau - CTX);
        if (act) {
            const u32x4 u0 = *(const u32x4*)(us + t * 16), u1 = *(const u32x4*)(us + t * 16 + 8);
            float u[16];
            u[0] = __uint_as_float(u0.x << 16); u[1] = __uint_as_float(u0.x & 0xffff0000u); u[2] = __uint_as_float(u0.y << 16); u[3] = __uint_as_float(u0.y & 0xffff0000u);
            u[4] = __uint_as_float(u0.z << 16); u[5] = __uint_as_float(u0.z & 0xffff0000u); u[6] = __uint_as_float(u0.w << 16); u[7] = __uint_as_float(u0.w & 0xffff0000u);
            u[8] = __uint_as_float(u1.x << 16); u[9] = __uint_as_float(u1.x & 0xffff0000u); u[10] = __uint_as_float(u1.y << 16); u[11] = __uint_as_float(u1.y & 0xffff0000u);
            u[12] = __uint_as_float(u1.z << 16); u[13] = __uint_as_float(u1.z & 0xffff0000u); u[14] = __uint_as_float(u1.w << 16); u[15] = __uint_as_float(u1.w & 0xffff0000u);
            float vr = 0.f, vi = 0.f;
#pragma unroll
            for (int c = 0; c < 16; ++c) { vr += br[c] * u[c]; vi += bi[c] * u[c]; }
            const float nr = ar * hr - ai * hi + vr, ni = ar * hi + ai * hr + vi; hr = nr; hi = ni;
            hs[(dir * 2 + 0) * 64 + p] = hr; hs[(dir * 2 + 1) * 64 + p] = hi;
        }
        __syncthreads();
        if (act && p < 16) { float y = 0.f; const float* cr = cs + (dir * 2 + 0) * 1024 + p * 64; const float* ci = cs + (dir * 2 + 1) * 1024 + p * 64; const float* h_r = hs + (dir * 2 + 0) * 64; const float* h_i = hs + (dir * 2 + 1) * 64;
#pragma unroll 16
            for (int q = 0; q < 64; ++q) y += cr[q] * h_r[q] - ci[q] * h_i[q];
            const int row = t < SEQ ? b * SEQ + t : NLAT + b * CTX + (t - SEQ);
            (dir ? yb : yf)[(size_t)row * DM + g * 16 + p] = y; }
        __syncthreads();
    }
}
__device__ __forceinline__ void s5_z_phase(const bf16_t* abuf, const float* dsk, const float* yf, const float* yb, bf16_t* z, size_t n4) {
    for (size_t i = (size_t)blockIdx.x * 512 + ltid(); i < n4; i += (size_t)gridDim.x * 512) {
        const int col = (int)((i * 4) & (DM - 1)); const u32x2 uu = *(const u32x2*)(abuf + i * 4); const f32x4 a = *(const f32x4*)(yf + i * 4), b = *(const f32x4*)(yb + i * 4), d = *(const f32x4*)(dsk + col);
        const float u0 = __uint_as_float(uu.x << 16), u1 = __uint_as_float(uu.x & 0xffff0000u), u2 = __uint_as_float(uu.y << 16), u3 = __uint_as_float(uu.y & 0xffff0000u);
        u32x2 w; w.x = pk2(gelu_tanh(d[0] * u0 + a[0] + b[0]), gelu_tanh(d[1] * u1 + a[1] + b[1])); w.y = pk2(gelu_tanh(d[2] * u2 + a[2] + b[2]), gelu_tanh(d[3] * u3 + a[3] + b[3]));
        *(u32x2*)(z + i * 4) = w; }
}

__device__ __forceinline__ void attn_naive_unit(const bf16_t* Q, const bf16_t* K, const bf16_t* Kpe, const bf16_t* V, bf16_t* out, int b, int h, int qi, int nk, int row) {
    const int sub = ltid() & 3;
    const bf16_t* qp = Q + ((size_t)(b * NH + h) * NKEY + qi) * DQK + 48 * sub;
    float q[48];
#pragma unroll
    for (int c = 0; c < 6; ++c) { const u32x4 w = *(const u32x4*)(qp + c * 8);
        q[c * 8 + 0] = __uint_as_float(w.x << 16); q[c * 8 + 1] = __uint_as_float(w.x & 0xffff0000u); q[c * 8 + 2] = __uint_as_float(w.y << 16); q[c * 8 + 3] = __uint_as_float(w.y & 0xffff0000u);
        q[c * 8 + 4] = __uint_as_float(w.z << 16); q[c * 8 + 5] = __uint_as_float(w.z & 0xffff0000u); q[c * 8 + 6] = __uint_as_float(w.w << 16); q[c * 8 + 7] = __uint_as_float(w.w & 0xffff0000u); }
    float o[32];
#pragma unroll
    for (int i = 0; i < 32; ++i) o[i] = 0.f;
    float m = -1e30f, l = 0.f;
    const bf16_t* Kh = K + (size_t)(b * NH + h) * NKEY * DN; const bf16_t* Vh = V + (size_t)(b * NH + h) * NKEY * DV; const bf16_t* Pb = Kpe + (size_t)b * NKEY * DR;
    for (int key = 0; key < nk; ++key) {
        float s = 0.f;
#pragma unroll
        for (int c = 0; c < 6; ++c) { const int d0 = 48 * sub + 8 * c;
            const bf16_t* kp = d0 < DN ? Kh + (size_t)key * DN + d0 : Pb + (size_t)key * DR + (d0 - DN);
            const u32x4 w = *(const u32x4*)kp;
            s += q[c * 8 + 0] * __uint_as_float(w.x << 16) + q[c * 8 + 1] * __uint_as_float(w.x & 0xffff0000u) + q[c * 8 + 2] * __uint_as_float(w.y << 16) + q[c * 8 + 3] * __uint_as_float(w.y & 0xffff0000u)
               + q[c * 8 + 4] * __uint_as_float(w.z << 16) + q[c * 8 + 5] * __uint_as_float(w.z & 0xffff0000u) + q[c * 8 + 6] * __uint_as_float(w.w << 16) + q[c * 8 + 7] * __uint_as_float(w.w & 0xffff0000u); }
        s += __shfl_xor(s, 1); s += __shfl_xor(s, 2);
        const float mn = fmaxf(m, s), alpha = exp2f(m - mn), pr = exp2f(s - mn); m = mn; l = l * alpha + pr;
        const bf16_t* vp = Vh + (size_t)key * DV + 32 * sub;
#pragma unroll
        for (int c = 0; c < 4; ++c) { const u32x4 w = *(const u32x4*)(vp + c * 8);
            o[c * 8 + 0] = o[c * 8 + 0] * alpha + pr * __uint_as_float(w.x << 16); o[c * 8 + 1] = o[c * 8 + 1] * alpha + pr * __uint_as_float(w.x & 0xffff0000u);
            o[c * 8 + 2] = o[c * 8 + 2] * alpha + pr * __uint_as_float(w.y << 16); o[c * 8 + 3] = o[c * 8 + 3] * alpha + pr * __uint_as_float(w.y & 0xffff0000u);
            o[c * 8 + 4] = o[c * 8 + 4] * alpha + pr * __uint_as_float(w.z << 16); o[c * 8 + 5] = o[c * 8 + 5] * alpha + pr * __uint_as_float(w.z & 0xffff0000u);
            o[c * 8 + 6] = o[c * 8 + 6] * alpha + pr * __uint_as_float(w.w << 16); o[c * 8 + 7] = o[c * 8 + 7] * alpha + pr * __uint_as_float(w.w & 0xffff0000u); }
    }
    const float il = 1.0f / l;
    bf16_t* op = out + (size_t)row * DM + h * DV + 32 * sub;
#pragma unroll
    for (int c = 0; c < 4; ++c) { u32x4 w; w.x = pk2(o[c * 8] * il, o[c * 8 + 1] * il); w.y = pk2(o[c * 8 + 2] * il, o[c * 8 + 3] * il); w.z = pk2(o[c * 8 + 4] * il, o[c * 8 + 5] * il); w.w = pk2(o[c * 8 + 6] * il, o[c * 8 + 7] * il);
        *(u32x4*)(op + c * 8) = w; }
}
__device__ __forceinline__ void attn_naive_phase(const bf16_t* Q, const bf16_t* K, const bf16_t* Kpe, const bf16_t* V, bf16_t* out, bool with_ctx) {
    const int ql = ltid() >> 2; const int nu = 1024 + (with_ctx ? 64 : 0);
    for (int u = blockIdx.x; u < nu; u += gridDim.x) {
        if (u < 1024) { const int bh = u >> 5, qb = u & 31, b = bh >> 4, h = bh & 15, l = qb * 128 + ql; attn_naive_unit(Q, K, Kpe, V, out, b, h, CTX + l, NKEY, b * SEQ + l); }
        else { const int uu = u - 1024, bh = uu >> 1, qb = uu & 1, b = bh >> 4, h = bh & 15, l = qb * 128 + ql; attn_naive_unit(Q, K, Kpe, V, out, b, h, l, CTX, NLAT + b * CTX + l); }
    }
}

template <class Epi> __device__ __forceinline__ void gemm_call(unsigned char* lds, const bf16_t* A, const bf16_t* Bt, int M, int N, int K, const Epi& E) {
    pg8::Gemm g; g.A = A; g.Bt = Bt; g.M = M; g.N = N; g.K = K;
    pg8::StaticOrder S; S.init(M, N, (int)gridDim.x, (int)blockIdx.x);
    pg8::gemm_phase<Epi, pg8::StaticOrder>((LAS unsigned char*)lds, g, S, E);
}
template <int PR> __device__ __forceinline__ void layer_pair(const P& p, unsigned char* shm, const XcdBarrier& bar) {
#define GSYNC() xcd_barrier(bar)
    char* ws = p.ws;
    float* mod = (float*)(ws + OFF_MOD); float* rope = (float*)(ws + OFF_ROPE); float* lamb = (float*)(ws + OFF_LAMB); float* bbar = (float*)(ws + OFF_BBAR);
    float* xs = (float*)(ws + OFF_XS); bf16_t* abuf = (bf16_t*)(ws + OFF_ABUF); bf16_t* zbuf = (bf16_t*)(ws + OFF_ZBUF); bf16_t* hbuf = (bf16_t*)(ws + OFF_HBUF);
    float* yf = (float*)(ws + OFF_YF); float* yb = (float*)(ws + OFF_YB); float* qc = (float*)(ws + OFF_QC); bf16_t* qn = (bf16_t*)(ws + OFF_QN); bf16_t* ckvn = (bf16_t*)(ws + OFF_CKVN);
    bf16_t* kpe = (bf16_t*)(ws + OFF_KPE); bf16_t* Qb = (bf16_t*)(ws + OFF_Q); bf16_t* Kb = (bf16_t*)(ws + OFF_K); bf16_t* Vb = (bf16_t*)(ws + OFF_V);
    const bf16_t* w1t = (const bf16_t*)(ws + OFF_W1T); const bf16_t* w2t = (const bf16_t*)(ws + OFF_W2T); const bf16_t* wglut = (const bf16_t*)(ws + OFF_WGLUT); const bf16_t* wot = (const bf16_t*)(ws + OFF_WOT);
    const bf16_t* wdqkvt = (const bf16_t*)(ws + OFF_WDQKVT); const bf16_t* wuqt = (const bf16_t*)(ws + OFF_WUQT); const bf16_t* wukvt = (const bf16_t*)(ws + OFF_WUKVT);
    const float qscale = 0.07216878364870322f * 1.4426950408889634f;
    { constexpr int i = 2 * PR, j = PR; const float* modl = mod + (size_t)i * 3 * 6 * DM;
      norm_mod_phase(xs, p.norm1_g + (size_t)i * DM, modl + 0 * DM, modl + 1 * DM, abuf, MROWS);
      GSYNC();
      for (int u = blockIdx.x; u < NG * NB; u += gridDim.x) s5_naive_unit(u >> 1, u & 1, abuf, lamb, bbar, p.c_re, p.c_im, j, yf, yb, shm);
      GSYNC();
      s5_z_phase(abuf, p.s5_d + (size_t)j * DM, yf, yb, zbuf, (size_t)MROWS * DM / 4);
      GSYNC();
      { Epi4<FGlu> e; e.f.xs = xs; e.f.g = modl + 2 * DM; e.f.z = zbuf; e.f.bglu = p.b_glu + (size_t)j * DM; gemm_call(shm, zbuf, wglut + (size_t)j * DM * DM, MROWS, DM, DM, e); }
      GSYNC();
      norm_mod_phase(xs, p.norm2_g + (size_t)i * DM, modl + 3 * DM, modl + 4 * DM, abuf, MROWS);
      GSYNC();
      { Epi8<FUp> e; e.f.h = hbuf; gemm_call(shm, abuf, w1t + (size_t)i * DFF * DM, MROWS, DFF, DM, e); }
      GSYNC();
      { Epi4<FRes> e; e.f.xs = xs; e.f.g = modl + 5 * DM; gemm_call(shm, hbuf, w2t + (size_t)i * DM * DFF, MROWS, DM, DFF, e); }
      GSYNC();
    }
    { constexpr int i = 2 * PR + 1, j = PR; constexpr bool last = (i == DEPTH - 1); constexpr int M = last ? NLAT : MROWS; const float* modl = mod + (size_t)i * 3 * 6 * DM;
      norm_mod_phase(xs, p.norm1_g + (size_t)i * DM, modl + 0 * DM, modl + 1 * DM, abuf, MROWS);
      GSYNC();
      { Epi4<FF32> e; e.f.C = qc; e.f.ldc = NDQKV; gemm_call(shm, abuf, wdqkvt + (size_t)j * NDQKV * DM, MROWS, NDQKV, DM, e); }
      GSYNC();
      mla_mid_phase(qc, p.q_norm + (size_t)j * QL, p.kv_norm + (size_t)j * KVL, rope, qn, ckvn, kpe, MROWS);
      GSYNC();
      { Epi8<FUq> e; e.f.Q = Qb; e.f.rope = rope; e.f.qscale = qscale; gemm_call(shm, qn, wuqt + (size_t)j * NH * DQK * QL, M, NH * DQK, QL, e); }
      { Epi8<FUkv> e; e.f.Kb = Kb; e.f.Vb = Vb; gemm_call(shm, ckvn, wukvt + (size_t)j * NH * (DN + DV) * KVL, MROWS, NH * (DN + DV), KVL, e); }
      GSYNC();
      attn_naive_phase(Qb, Kb, kpe, Vb, abuf, !last);
      GSYNC();
      { Epi4<FRes> e; e.f.xs = xs; e.f.g = modl + 2 * DM; gemm_call(shm, abuf, wot + (size_t)j * DM * DM, M, DM, DM, e); }
      GSYNC();
      norm_mod_phase(xs, p.norm2_g + (size_t)i * DM, modl + 3 * DM, modl + 4 * DM, abuf, M);
      GSYNC();
      { Epi8<FUp> e; e.f.h = hbuf; gemm_call(shm, abuf, w1t + (size_t)i * DFF * DM, M, DFF, DM, e); }
      GSYNC();
      { Epi4<FRes> e; e.f.xs = xs; e.f.g = modl + 5 * DM; gemm_call(shm, hbuf, w2t + (size_t)i * DM * DFF, M, DM, DFF, e); }
      GSYNC();
    }
#undef GSYNC
}
__global__ void __launch_bounds__(512, 2) mega(P p) {
    extern __shared__ __attribute__((aligned(16))) unsigned char shm[];
    if (threadIdx.x < 4) ((unsigned*)(shm + LDS_CTL))[threadIdx.x] = 0u;
    __syncthreads();
    XcdBarrier bar = xcd_barrier_post((unsigned*)(p.ws + OFF_BAR), (volatile LAS unsigned*)(shm + LDS_CTL));
    prologue_phase(p, shm);
    xcd_barrier(bar);
    layer_pair<0>(p, shm, bar);
    layer_pair<1>(p, shm, bar);
    final_norm_phase((const float*)(p.ws + OFF_XS), p.final_g, p.out);
}

extern "C" void kernel_launch(void* const* d_in, const int* in_sizes, int n_in, void* d_out, int out_size, void* d_ws, size_t ws_size, hipStream_t stream) {
    if (n_in != 28 || ws_size < WS_END) { fprintf(stderr, "kernel_launch: unexpected inputs (%d) or workspace (%zu < %zu)\n", n_in, ws_size, (size_t)WS_END); return; }
    static int grid = 0;
    if (!grid) {
        int dev = 0, cus = 0, per_cu = 0;
        (void)hipGetDevice(&dev); (void)hipDeviceGetAttribute(&cus, hipDeviceAttributeMultiprocessorCount, dev);
        if (hipFuncSetAttribute((const void*)mega, hipFuncAttributeMaxDynamicSharedMemorySize, LDS_BYTES) != hipSuccess) { fprintf(stderr, "kernel_launch: hipFuncSetAttribute failed\n"); return; }
        if (hipOccupancyMaxActiveBlocksPerMultiprocessor(&per_cu, (const void*)mega, 512, LDS_BYTES) != hipSuccess || per_cu < 1) fprintf(stderr, "kernel_launch: occupancy query says %d blocks per CU\n", per_cu);
        grid = cus > 0 ? cus : 256;
    }
    P p; memset(&p, 0, sizeof(p));
    const float** fp = (const float**)&p;
    for (int i = 0; i < 28; ++i) fp[i] = (const float*)d_in[i];
    p.out = (float*)d_out; p.ws = (char*)d_ws;
    float* xs = (float*)(p.ws + OFF_XS);
    (void)hipMemsetAsync(p.ws + OFF_BAR, 0, XCD_BAR_WORDS * sizeof(unsigned), stream);
    (void)hipMemcpyAsync(xs, p.x, (size_t)NLAT * DM * 4, hipMemcpyDeviceToDevice, stream);
    (void)hipMemcpyAsync(xs + (size_t)NLAT * DM, p.ctx, (size_t)NCTX * DM * 4, hipMemcpyDeviceToDevice, stream);
    hipLaunchKernelGGL(mega, dim3(grid), dim3(512), LDS_BYTES, stream, p);
    const hipError_t le = hipPeekAtLastError();
    if (le != hipSuccess) fprintf(stderr, "kernel_launch: launch failed: %s\n", hipGetErrorName(le));
}
```

```cpp
#include <hip/hip_runtime.h>
#include <stdint.h>
#include <cstdio>
#include <cstring>

#define LAS __attribute__((address_space(3)))
typedef unsigned short bf16_t;
typedef short bf16x8 __attribute__((ext_vector_type(8)));
typedef float f32x4 __attribute__((ext_vector_type(4)));
typedef float f32x2 __attribute__((ext_vector_type(2)));
typedef unsigned u32x4 __attribute__((ext_vector_type(4)));
typedef unsigned u32x2 __attribute__((ext_vector_type(2)));

constexpr int DM = 2048, NB = 2, SEQ = 4096, CTX = 256, DEPTH = 4, DFF = 8192;
constexpr int NLAT = NB * SEQ, NCTX = NB * CTX, MROWS = NLAT + NCTX;
constexpr int NKEY = CTX + SEQ;
constexpr int NG = 128, NP = 64, GC = 16;
constexpr int NH = 16, QL = 512, KVL = 512, DN = 128, DR = 64, DV = 128, DQK = DN + DR;
constexpr int NDQKV = 1280;
constexpr float EPS = 1e-6f;

constexpr size_t al256(size_t x) { return (x + 255) & ~(size_t)255; }
constexpr size_t OFF_BAR = 0;
constexpr size_t OFF_MOD = 16384;
constexpr size_t OFF_ROPE = OFF_MOD + al256((size_t)DEPTH * 3 * 6 * DM * 4);
constexpr size_t OFF_LAMB = OFF_ROPE + al256((size_t)SEQ * 2 * 16 * 2 * 4);
constexpr size_t OFF_BBAR = OFF_LAMB + al256((size_t)2 * 2 * NG * NP * 2 * 4);
constexpr size_t OFF_XS = OFF_BBAR + al256((size_t)2 * 2 * NG * NP * GC * 2 * 4);
constexpr size_t OFF_ABUF = OFF_XS + al256((size_t)MROWS * DM * 4);
constexpr size_t OFF_ZBUF = OFF_ABUF + al256((size_t)MROWS * DM * 2);
constexpr size_t OFF_HBUF = OFF_ZBUF + al256((size_t)MROWS * DM * 2);
constexpr size_t OFF_YF = OFF_HBUF + al256((size_t)MROWS * DFF * 2);
constexpr size_t OFF_YB = OFF_YF + al256((size_t)MROWS * DM * 4);
constexpr size_t OFF_S5T = OFF_YB;
constexpr size_t OFF_QC = OFF_YB + al256((size_t)MROWS * DM * 4);
constexpr size_t OFF_QN = OFF_QC + al256((size_t)MROWS * NDQKV * 4);
constexpr size_t OFF_CKVN = OFF_QN + al256((size_t)MROWS * QL * 2);
constexpr size_t OFF_KPE = OFF_CKVN + al256((size_t)MROWS * KVL * 2);
constexpr size_t OFF_Q = OFF_KPE + al256((size_t)NB * NKEY * DR * 2);
constexpr size_t OFF_K = OFF_Q + al256((size_t)NB * NH * NKEY * DQK * 2);
constexpr size_t OFF_V = OFF_K + al256((size_t)NB * NH * NKEY * DN * 2);
constexpr size_t OFF_W1T = OFF_V + al256((size_t)NB * NH * NKEY * DV * 2);
constexpr size_t OFF_W2T = OFF_W1T + (size_t)DEPTH * DFF * DM * 2;
constexpr size_t OFF_WGLUT = OFF_W2T + (size_t)DEPTH * DFF * DM * 2;
constexpr size_t OFF_WOT = OFF_WGLUT + (size_t)2 * DM * DM * 2;
constexpr size_t OFF_WDQKVT = OFF_WOT + (size_t)2 * DM * DM * 2;
constexpr size_t OFF_WUQT = OFF_WDQKVT + (size_t)2 * NDQKV * DM * 2;
constexpr size_t OFF_WUKVT = OFF_WUQT + (size_t)2 * NH * DQK * QL * 2;
constexpr size_t WS_END = OFF_WUKVT + (size_t)2 * NH * (DN + DV) * KVL * 2;

__device__ __forceinline__ float bf2f(bf16_t b) { return __uint_as_float(((unsigned)b) << 16); }
__device__ __forceinline__ bf16_t f2bf(float f) { unsigned u = __float_as_uint(f); u += 0x7FFFu + ((u >> 16) & 1u); return (bf16_t)(u >> 16); }
__device__ __forceinline__ unsigned pk2(float lo, float hi) { return (unsigned)f2bf(lo) | ((unsigned)f2bf(hi) << 16); }
__device__ __forceinline__ float wave_sum(float v) {
#pragma unroll
    for (int o = 32; o >= 1; o >>= 1) v += __shfl_xor(v, o);
    return v;
}
__device__ __forceinline__ float sigmoidf_(float x) { return 1.0f / (1.0f + __expf(-x)); }
__device__ __forceinline__ float gelu_tanh(float x) { const float u = 0.7978845608028654f * (x + 0.044715f * x * x * x); return 0.5f * x * (1.0f + tanhf(u)); }
__device__ __forceinline__ void sincos_d(double a, double& s, double& c) {
    const double kd = rint(a * 0.63661977236758134308);
    double r = fma(-kd, 1.57079632679489655800e+00, a); r = fma(-kd, 6.12323399573676603587e-17, r);
    const long long k = (long long)kd; const double r2 = r * r;
    const double sp = r * (1.0 + r2 * (-1.0 / 6 + r2 * (1.0 / 120 + r2 * (-1.0 / 5040 + r2 * (1.0 / 362880 + r2 * (-1.0 / 39916800 + r2 * (1.0 / 6227020800.0)))))));
    const double cp = 1.0 + r2 * (-0.5 + r2 * (1.0 / 24 + r2 * (-1.0 / 720 + r2 * (1.0 / 40320 + r2 * (-1.0 / 3628800 + r2 * (1.0 / 479001600.0 + r2 * (-1.0 / 87178291200.0)))))));
    const int q = (int)(k & 3);
    s = (q == 0) ? sp : (q == 1) ? cp : (q == 2) ? -sp : -cp;
    c = (q == 0) ? cp : (q == 1) ? -sp : (q == 2) ? -cp : sp;
}
__device__ __forceinline__ int rope_srcd(int dp) { return (dp & 32) + (dp & 1) * 16 + ((dp & 31) >> 1); }

__device__ __forceinline__ int ltid() {
    const int w = __builtin_amdgcn_readfirstlane((int)threadIdx.x >> 6);
    int l; asm volatile("v_mbcnt_lo_u32_b32 %0, -1, 0\n\tv_mbcnt_hi_u32_b32 %0, -1, %0" : "=v"(l));
    int t; asm volatile("v_lshl_or_b32 %0, %1, 6, %2" : "=v"(t) : "s"(w), "v"(l));
    return t; }

namespace pg8 {
constexpr int BM = 256, BK = 64, HALF = 128, HTB = HALF * BK * 2, STAGE_BYTES = 8 * HTB, NXCD = 8, WGM = 8;
__host__ __device__ __forceinline__ int lds_byte(int r, int c) { const int st = (r >> 4) * 2 + (c >> 5), rr = r & 15, cc = c & 31, ob = rr * 64 + cc * 2; return st * 1024 + (ob ^ (((ob >> 9) & 1) << 5)); }
__host__ __device__ __forceinline__ void stage_rc(int b, int& R, int& C) { const int st = b / 1024, sb = b % 1024, swz = sb ^ (((sb >> 9) & 1) << 5); R = (st >> 1) * 16 + swz / 64; C = (st & 1) * 32 + (swz % 64) / 2; }
__host__ __device__ __forceinline__ int perm32(int rho) { const int n = rho >> 4, i = rho & 15; return 8 * (i >> 2) + 4 * n + (i & 3); }
struct Unit { int pm, pn; };
struct Gemm { const bf16_t* A; const bf16_t* Bt; int M, N, K; };
struct StaticOrder {
    int nM, nN, nwg, G, c;
    __host__ __device__ void init(int M, int N, int G_, int c_) { nM = M / BM; nN = N / BM; nwg = nM * nN; G = G_; c = c_; }
    __host__ __device__ bool next(int i, Unit& u) const {
        const long L = (long)i * G + c; if (L >= nwg) return false;
        int wgid = (int)L; { const int q = nwg / NXCD, r = nwg % NXCD, xcd = wgid % NXCD, off = wgid / NXCD; wgid = (xcd < r ? xcd * (q + 1) : r * (q + 1) + (xcd - r) * q) + off; }
        const int nig = WGM * nN, gid = wgid / nig, fm = gid * WGM, gsz = (nM - fm) < WGM ? (nM - fm) : WGM;
        u.pm = fm + ((wgid % nig) % gsz); u.pn = (wgid % nig) / gsz; return true;
    }
    __device__ __forceinline__ void a_ready(const Unit&) const {}
    __device__ __forceinline__ void done(const Unit&) const {}
};
template <class Epi, class Sched>
__device__ __forceinline__ void gemm_phase(LAS unsigned char* lds, const Gemm g, const Sched& S, const Epi& E) {
    const int tid = ltid(), wid = __builtin_amdgcn_readfirstlane(tid >> 6), lane = tid & 63, wr = wid >> 2, wc = wid & 3, fr = lane & 15, fq = lane >> 4;
    const int K = g.K, nt = K / BK;
    unsigned voffA[2], voffB[2];
#pragma unroll
    for (int i = 0; i < 2; ++i) { int R, C; stage_rc(tid * 16 + i * 8192, R, C); const int Rb = Epi::PERM ? ((R & ~31) + perm32(R & 31)) : R;
        voffA[i] = (unsigned)(R * K + C) * 2u; voffB[i] = (unsigned)(Rb * K + C) * 2u; }
    const size_t kstep = (size_t)(BK * 2);
    const size_t hstep = (size_t)HALF * K * 2;
    const size_t tstep = 2 * hstep;
    const unsigned ldsw = (unsigned)wid * 1024u;
    const int aoff = lds_byte(wr * 64 + fr, fq * 8), boff = lds_byte(wc * 32 + fr, fq * 8);
#define PG8_SA(b, h) (((b) * 2 + (h)) * HTB)
#define PG8_SB(b, h) ((4 + (b) * 2 + (h)) * HTB)
#define PG8_STAGE(bufoff, gbase, voff) do { _Pragma("unroll") for (int _i = 0; _i < 2; ++_i) \
        __builtin_amdgcn_global_load_lds((const unsigned*)((const char*)(gbase) + (voff)[_i]), (LAS unsigned*)(lds + (bufoff) + ldsw + _i * 8192), 16, 0, 0); } while (0)
#define PG8_LDA(dst, b, h) do { _Pragma("unroll") for (int m = 0; m < 4; ++m) _Pragma("unroll") for (int k = 0; k < 2; ++k) dst[m][k] = *(const LAS bf16x8*)(lds + PG8_SA(b, h) + aoff + m * 2048 + k * 1024); } while (0)
#define PG8_LDB(dst, b, h) do { _Pragma("unroll") for (int n = 0; n < 2; ++n) _Pragma("unroll") for (int k = 0; k < 2; ++k) dst[n][k] = *(const LAS bf16x8*)(lds + PG8_SB(b, h) + boff + n * 2048 + k * 1024); } while (0)
#define PG8_MMA(ai, bj, At, Bt) do { __builtin_amdgcn_s_setprio(1); _Pragma("unroll") for (int m = 0; m < 4; ++m) _Pragma("unroll") for (int n = 0; n < 2; ++n) _Pragma("unroll") for (int k = 0; k < 2; ++k) \
        acc[ai][bj][m][n] = __builtin_amdgcn_mfma_f32_16x16x32_bf16(Bt[n][k], At[m][k], acc[ai][bj][m][n], 0, 0, 0); __builtin_amdgcn_s_setprio(0); } while (0)
#define PG8_WAIT_V(n) asm volatile("s_waitcnt vmcnt(" #n ")" ::: "memory")
#define PG8_WAIT_L(n) asm volatile("s_waitcnt lgkmcnt(" #n ")" ::: "memory")
#define PG8_BAR __builtin_amdgcn_s_barrier()
#define PG8_SCHED __builtin_amdgcn_sched_barrier(0)
    Unit cur, nxt; int ui = 0;
    if (!S.next(0, cur)) return;
    f32x4 acc[2][2][4][2];
#pragma unroll
    for (int a = 0; a < 2; ++a)
#pragma unroll
        for (int b = 0; b < 2; ++b)
#pragma unroll
            for (int m = 0; m < 4; ++m)
#pragma unroll
                for (int n = 0; n < 2; ++n) acc[a][b][m][n] = (f32x4){0.f, 0.f, 0.f, 0.f};
    bf16x8 At[4][2], B0[2][2], B1[2][2];
    const char* cA = (const char*)g.A + (size_t)cur.pm * tstep; const char* cB = (const char*)g.Bt + (size_t)cur.pn * tstep;
    S.a_ready(cur);
    PG8_STAGE(PG8_SB(0, 0), cB, voffB); PG8_STAGE(PG8_SA(0, 0), cA, voffA); PG8_STAGE(PG8_SB(0, 1), cB + hstep, voffB); PG8_STAGE(PG8_SA(0, 1), cA + hstep, voffA);
    if (wr == 1) PG8_BAR;
    PG8_WAIT_V(4); PG8_BAR;
    PG8_STAGE(PG8_SB(1, 0), cB + kstep, voffB); PG8_STAGE(PG8_SA(1, 0), cA + kstep, voffA); PG8_STAGE(PG8_SB(1, 1), cB + hstep + kstep, voffB);
    PG8_WAIT_V(6); PG8_BAR;
    for (;;) {
        const bool has_next = S.next(ui + 1, nxt);
        const char* nA = has_next ? (const char*)g.A + (size_t)nxt.pm * tstep : cA; const char* nB = has_next ? (const char*)g.Bt + (size_t)nxt.pn * tstep : cB;
        for (int t = 0; t < nt; t += 2) {
            const bool last = (t == nt - 2);
            const char* a1 = cA + (size_t)(t + 1) * kstep;
            const char* a2 = last ? nA : cA + (size_t)(t + 2) * kstep; const char* b2 = last ? nB : cB + (size_t)(t + 2) * kstep;
            const char* a3 = a2 + kstep; const char* b3 = b2 + kstep;
            if (last && has_next) S.a_ready(nxt);
            PG8_LDB(B0, 0, 0); PG8_SCHED; PG8_LDA(At, 0, 0); PG8_STAGE(PG8_SA(1, 1), a1 + hstep, voffA);
            PG8_WAIT_L(8); PG8_BAR; PG8_WAIT_L(0); PG8_MMA(0, 0, At, B0); PG8_BAR; PG8_SCHED;
            PG8_LDB(B1, 0, 1); PG8_STAGE(PG8_SB(0, 0), b2, voffB);
            PG8_BAR; PG8_WAIT_L(0); PG8_MMA(0, 1, At, B1); PG8_BAR;
            PG8_LDA(At, 0, 1); PG8_STAGE(PG8_SA(0, 0), a2, voffA);
            PG8_BAR; PG8_WAIT_L(0); PG8_MMA(1, 0, At, B0); PG8_BAR; PG8_SCHED;
            PG8_STAGE(PG8_SB(0, 1), b2 + hstep, voffB);
            PG8_WAIT_V(6); PG8_BAR; PG8_MMA(1, 1, At, B1); PG8_BAR;
            PG8_LDB(B0, 1, 0); PG8_SCHED; PG8_LDA(At, 1, 0); PG8_STAGE(PG8_SA(0, 1), a2 + hstep, voffA);
            PG8_WAIT_L(8); PG8_BAR; PG8_WAIT_L(0); PG8_MMA(0, 0, At, B0); PG8_BAR; PG8_SCHED;
            PG8_LDB(B1, 1, 1); PG8_STAGE(PG8_SB(1, 0), b3, voffB);
            PG8_BAR; PG8_WAIT_L(0); PG8_MMA(0, 1, At, B1); PG8_BAR;
            PG8_LDA(At, 1, 1); PG8_STAGE(PG8_SA(1, 0), a3, voffA);
            PG8_BAR; PG8_WAIT_L(0); PG8_MMA(1, 0, At, B0); PG8_BAR; PG8_SCHED;
            PG8_STAGE(PG8_SB(1, 1), b3 + hstep, voffB);
            PG8_WAIT_V(6); PG8_BAR; PG8_MMA(1, 1, At, B1); PG8_BAR;
        }
        E(acc, cur, wr, wc, fr, fq); S.done(cur);
        if (!has_next) break;
#pragma unroll
        for (int a = 0; a < 2; ++a)
#pragma unroll
            for (int b = 0; b < 2; ++b)
#pragma unroll
                for (int m = 0; m < 4; ++m)
#pragma unroll
                    for (int n = 0; n < 2; ++n) acc[a][b][m][n] = (f32x4){0.f, 0.f, 0.f, 0.f};
        cur = nxt; cA = nA; cB = nB; ++ui;
    }
    PG8_WAIT_V(0);
    if (wr == 0) PG8_BAR;
    PG8_BAR;
#undef PG8_SA
#undef PG8_SB
#undef PG8_STAGE
#undef PG8_LDA
#undef PG8_LDB
#undef PG8_MMA
#undef PG8_WAIT_V
#undef PG8_WAIT_L
#undef PG8_BAR
#undef PG8_SCHED
}
}

template <class F> struct Epi4 {
    static constexpr bool PERM = false, AFTER_DRAIN = false; F f;
    __device__ __forceinline__ void operator()(const f32x4 (&acc)[2][2][4][2], const pg8::Unit& u, int wr, int wc, int fr, int fq) const {
#pragma unroll
        for (int ai = 0; ai < 2; ++ai)
#pragma unroll
            for (int m = 0; m < 4; ++m) { const int row = u.pm * 256 + ai * 128 + wr * 64 + m * 16 + fr;
#pragma unroll
                for (int bj = 0; bj < 2; ++bj)
#pragma unroll
                    for (int n = 0; n < 2; ++n) f(row, u.pn * 256 + bj * 128 + wc * 32 + n * 16 + 4 * fq, acc[ai][bj][m][n]); }
    }
};
template <class F> struct Epi8 {
    static constexpr bool PERM = true, AFTER_DRAIN = false; F f;
    __device__ __forceinline__ void operator()(const f32x4 (&acc)[2][2][4][2], const pg8::Unit& u, int wr, int wc, int fr, int fq) const {
#pragma unroll
        for (int ai = 0; ai < 2; ++ai)
#pragma unroll
            for (int m = 0; m < 4; ++m) { const int row = u.pm * 256 + ai * 128 + wr * 64 + m * 16 + fr;
#pragma unroll
                for (int bj = 0; bj < 2; ++bj) f(row, u.pn * 256 + bj * 128 + wc * 32 + 8 * fq, acc[ai][bj][m][0], acc[ai][bj][m][1]); }
    }
};
__device__ __forceinline__ int modrow(int row) { return row < NLAT ? (row >> 12) : 2; }
struct FRes { float* xs; const float* g;
    __device__ __forceinline__ void operator()(int row, int col, f32x4 v) const {
        float* p = xs + (size_t)row * DM + col; const f32x4 gg = *(const f32x4*)(g + modrow(row) * 6 * DM + col);
        f32x4 x = *(const f32x4*)p; x += gg * v; *(f32x4*)p = x; } };
struct FGlu { float* xs; const float* g; const bf16_t* z; const float* bglu;
    __device__ __forceinline__ void operator()(int row, int col, f32x4 v) const {
        float* p = xs + (size_t)row * DM + col; const f32x4 gg = *(const f32x4*)(g + modrow(row) * 6 * DM + col); const f32x4 bb = *(const f32x4*)(bglu + col);
        const u32x2 zz = *(const u32x2*)(z + (size_t)row * DM + col);
        const float z0 = __uint_as_float(zz.x << 16), z1 = __uint_as_float(zz.x & 0xffff0000u), z2 = __uint_as_float(zz.y << 16), z3 = __uint_as_float(zz.y & 0xffff0000u);
        f32x4 x = *(const f32x4*)p;
        x[0] += gg[0] * z0 * sigmoidf_(v[0] + bb[0]); x[1] += gg[1] * z1 * sigmoidf_(v[1] + bb[1]);
        x[2] += gg[2] * z2 * sigmoidf_(v[2] + bb[2]); x[3] += gg[3] * z3 * sigmoidf_(v[3] + bb[3]);
        *(f32x4*)p = x; } };
struct FUp { bf16_t* h;
    __device__ __forceinline__ void operator()(int row, int col, f32x4 a, f32x4 b) const {
        f32x4 r0 = __builtin_elementwise_max(a, (f32x4){0.f, 0.f, 0.f, 0.f}), r1 = __builtin_elementwise_max(b, (f32x4){0.f, 0.f, 0.f, 0.f}); r0 *= r0; r1 *= r1;
        u32x4 w; w.x = pk2(r0[0], r0[1]); w.y = pk2(r0[2], r0[3]); w.z = pk2(r1[0], r1[1]); w.w = pk2(r1[2], r1[3]);
        *(u32x4*)(h + (size_t)row * DFF + col) = w; } };
struct FF32 { float* C; int ldc;
    __device__ __forceinline__ void operator()(int row, int col, f32x4 v) const { *(f32x4*)(C + (size_t)row * ldc + col) = v; } };
__device__ __forceinline__ void row_bk(int row, int& b, int& key, int& lpos) {
    if (row < NLAT) { b = row >> 12; lpos = row & (SEQ - 1); key = CTX + lpos; } else { const int r = row - NLAT; b = r >> 8; key = r & (CTX - 1); lpos = -1; } }
struct FUq { bf16_t* Q; const float* rope; float qscale;
    __device__ __forceinline__ void operator()(int row, int col, f32x4 a, f32x4 b) const {
        int bb, key, lpos; row_bk(row, bb, key, lpos);
        const int h = col / DQK, e = col - h * DQK;
        if (e >= DN && lpos >= 0) { const int ep = e - DN, axis = ep >> 5, f0 = (ep & 31) >> 1;
            const f32x4 cs0 = *(const f32x4*)(rope + ((size_t)(lpos * 2 + axis) * 16 + f0) * 2), cs1 = *(const f32x4*)(rope + ((size_t)(lpos * 2 + axis) * 16 + f0 + 2) * 2);
            f32x4 na, nb;
            na[0] = a[0] * cs0[0] - a[1] * cs0[1]; na[1] = a[0] * cs0[1] + a[1] * cs0[0]; na[2] = a[2] * cs0[2] - a[3] * cs0[3]; na[3] = a[2] * cs0[3] + a[3] * cs0[2];
            nb[0] = b[0] * cs1[0] - b[1] * cs1[1]; nb[1] = b[0] * cs1[1] + b[1] * cs1[0]; nb[2] = b[2] * cs1[2] - b[3] * cs1[3]; nb[3] = b[2] * cs1[3] + b[3] * cs1[2];
            a = na; b = nb; }
        a *= qscale; b *= qscale;
        u32x4 w; w.x = pk2(a[0], a[1]); w.y = pk2(a[2], a[3]); w.z = pk2(b[0], b[1]); w.w = pk2(b[2], b[3]);
        *(u32x4*)(Q + ((size_t)(bb * NH + h) * NKEY + key) * DQK + e) = w; } };
struct FUkv { bf16_t* Kb; bf16_t* Vb;
    __device__ __forceinline__ void operator()(int row, int col, f32x4 a, f32x4 b) const {
        int bb, key, lpos; row_bk(row, bb, key, lpos);
        const int h = col >> 8, e = col & 255;
        u32x4 w; w.x = pk2(a[0], a[1]); w.y = pk2(a[2], a[3]); w.z = pk2(b[0], b[1]); w.w = pk2(b[2], b[3]);
        bf16_t* dst = (e < DN ? Kb : Vb) + ((size_t)(bb * NH + h) * NKEY + key) * DN + (e & 127);
        *(u32x4*)dst = w; } };

#define XB_TMO      128
#define XB_XCNT(j)  (256  + 64 * (j))
#define XB_XSUB(j)  (1280 + 64 * (j))
#define XB_XGEN(j)  (2304 + 64 * (j))
#define XB_TOP      3328
#define XB_TOPGEN   3392
#define XCD_BAR_WORDS 3456
#define XB_SPIN_CAP (1u << 18)
__device__ __forceinline__ unsigned xb_ld(unsigned* p)              { return __hip_atomic_load(p, __ATOMIC_RELAXED, __HIP_MEMORY_SCOPE_AGENT); }
__device__ __forceinline__ unsigned xb_add(unsigned* p, unsigned v) { return __hip_atomic_fetch_add(p, v, __ATOMIC_RELAXED, __HIP_MEMORY_SCOPE_AGENT); }
__device__ __forceinline__ unsigned xb_xcc_id() { return (unsigned)__builtin_amdgcn_s_getreg((3 << 11) | 20) & 0xFu; }
#define XB_SPIN(cond, bar) do { unsigned _sp = 0; while (cond) { __builtin_amdgcn_s_sleep(1); \
    if ((++_sp & 255u) == 0u) { if (xb_ld(&(bar)[XB_TMO])) break; if (_sp > XB_SPIN_CAP) { atomicAdd(&(bar)[XB_TMO], 1u); break; } } } } while (0)
struct XcdBarrier { unsigned* bar; unsigned x; volatile LAS unsigned* st; };
__device__ __forceinline__ XcdBarrier xcd_barrier_post(unsigned* bar, volatile LAS unsigned* st) {
    XcdBarrier b; b.bar = bar; b.x = xb_xcc_id(); b.st = st;
    if (threadIdx.x == 0) (void)xb_add(&bar[XB_XCNT(b.x)], 1u);
    return b;
}
__device__ __forceinline__ void xcd_barrier_complete(unsigned* bar, unsigned x, unsigned& nloc, unsigned& nx) {
    const unsigned G = gridDim.x * gridDim.y * gridDim.z;
    unsigned sum, cnt, mine, sp = 0u;
    for (;;) {
        sum = 0u; cnt = 0u; mine = 0u;
#pragma unroll
        for (unsigned j = 0; j < 16; ++j) { const unsigned c = xb_ld(&bar[XB_XCNT(j)]); sum += c; cnt += (c > 0u) ? 1u : 0u; mine = (j == x) ? c : mine; }
        if (sum == G) break;
        __builtin_amdgcn_s_sleep(1);
        if ((++sp & 255u) == 0u) { if (xb_ld(&bar[XB_TMO])) break; if (sp > XB_SPIN_CAP) { atomicAdd(&bar[XB_TMO], 1u); break; } }
    }
    nloc = mine > 0u ? mine : 1u; nx = cnt > 0u ? cnt : 1u;
}
__device__ __forceinline__ void xcd_barrier(const XcdBarrier& b) {
    asm volatile("s_waitcnt vmcnt(0)" ::: "memory");
    __syncthreads();
    if (threadIdx.x == 0) {
        unsigned* bar = b.bar;
        __builtin_amdgcn_s_waitcnt(0);
        unsigned nloc = b.st[0], nx = b.st[1];
        if (nloc == 0u) { xcd_barrier_complete(bar, b.x, nloc, nx); b.st[0] = nloc; b.st[1] = nx; }
        const unsigned old = xb_add(&bar[XB_XSUB(b.x)], 1u);
        const unsigned gen = old / nloc;
        if (old + 1u == (gen + 1u) * nloc) {
            __builtin_amdgcn_fence(__ATOMIC_RELEASE, "agent");
            asm volatile("s_waitcnt vmcnt(0)" ::: "memory");
            const unsigned og = xb_add(&bar[XB_TOP], 1u);
            const unsigned tg = og / nx;
            if (og + 1u == (tg + 1u) * nx) xb_add(&bar[XB_TOPGEN], 1u);
            else XB_SPIN(xb_ld(&bar[XB_TOPGEN]) == tg, bar);
            __builtin_amdgcn_fence(__ATOMIC_ACQUIRE, "agent");
            xb_add(&bar[XB_XGEN(b.x)], 1u);
            asm volatile("s_waitcnt vmcnt(0)" ::: "memory");
        } else {
            XB_SPIN(xb_ld(&bar[XB_XGEN(b.x)]) == gen, bar);
            __builtin_amdgcn_fence(__ATOMIC_ACQUIRE, "agent");
            asm volatile("s_waitcnt vmcnt(0)" ::: "memory");
        }
    }
    __syncthreads();
}

struct P {
    const float *x, *c, *ctx, *cctx, *ada_w, *ada_b, *norm1_g, *norm2_g, *final_g, *lam_re, *lam_im, *log_dt, *b_re, *b_im, *c_re, *c_im, *s5_d, *w_glu, *b_glu;
    const float *w_dq, *q_norm, *w_uq, *w_dkv, *kv_norm, *w_ukv, *w_o, *ffn_w1, *ffn_w2;
    float* out; char* ws;
};
constexpr int LDS_BYTES = 163840;
constexpr int LDS_CTL = LDS_BYTES - 16;
typedef const __attribute__((address_space(4))) P* KP;
__device__ __forceinline__ KP kp() { KP k = (KP)__builtin_amdgcn_kernarg_segment_ptr(); asm volatile("" : "+s"(k)); return k; }

namespace s5f {
constexpr int NTILE = 34;
constexpr int TB_PT = 0, TB_QT = 32768, TB_KT = 65536, TB_LP = 73728, TB_STRIDE = 77824;
constexpr int L_PT = 0, L_QT = 32768, L_KT = 65536, L_HB = 73728, HB_ROW = 272, HB_WAVE = 16 * HB_ROW, L_ET = L_HB + 8 * HB_WAVE, L_END = L_ET + NTILE * 128 * 4;
typedef float f32x2v __attribute__((ext_vector_type(2)));
__device__ __forceinline__ f32x2v cmul(f32x2v a, f32x2v b) { return (f32x2v){a.x * b.x - a.y * b.y, a.x * b.y + a.y * b.x}; }

__device__ __forceinline__ void make_tables(int jdg, const P& p, char* tb, char* lds) {
    const int tid = ltid();
    f32x2v* lp = (f32x2v*)lds;
    f32x2v* bb = lp + 9 * 64;
    f32x2v* cc = bb + 64 * 16;
    float* kd = (float*)(cc + 16 * 64);
    __syncthreads();
    if (tid < 64) { const int i = jdg * 64 + tid;
        const double dt = exp((double)p.log_dt[jdg]); const double lr = p.lam_re[i], li = p.lam_im[i];
        float* lpo = (float*)(tb + TB_LP);
#pragma unroll 1
        for (int k = 0; k <= 12; ++k) { const int e = k <= 8 ? k : (k - 8) * 32;
            const double mag = exp(lr * dt * e); double sn, cs; sincos_d(li * dt * e, sn, cs);
            const f32x2v v = {(float)(mag * cs), (float)(mag * sn)};
            if (k <= 8) lp[k * 64 + tid] = v;
            if (k >= 8) { lpo[((k - 8) * 64 + tid) * 2] = v.x; lpo[((k - 8) * 64 + tid) * 2 + 1] = v.y; } }
        const double mag = exp(lr * dt); double sn, cs; sincos_d(li * dt, sn, cs);
        const double lbr = mag * cs, lbi = mag * sn, nr = lbr - 1.0, den = lr * lr + li * li;
        const double fr = (nr * lr + lbi * li) / den, fi = (lbi * lr - nr * li) / den;
#pragma unroll 1
        for (int c = 0; c < GC; ++c) { const double br = p.b_re[(size_t)i * GC + c], bi = p.b_im[(size_t)i * GC + c];
            bb[tid * 16 + c] = (f32x2v){(float)(fr * br - fi * bi), (float)(fr * bi + fi * br)}; } }
    for (int i = tid; i < 1024; i += 512) cc[i] = (f32x2v){p.c_re[(size_t)jdg * 1024 + i], p.c_im[(size_t)jdg * 1024 + i]};
    __syncthreads();
    for (int o = tid; o < 2048; o += 512) { const int d = o >> 8, co = (o >> 4) & 15, ci = o & 15; float s = 0.f;
        for (int q = 0; q < 64; ++q) { const f32x2v w = cmul(cc[co * 64 + q], lp[d * 64 + q]); const f32x2v b = bb[q * 16 + ci]; s += w.x * b.x - w.y * b.y; }
        kd[o] = s; }
    for (int f = tid; f < 2048; f += 512) { const int nt = f >> 8, kk = (f >> 6) & 3, l = f & 63;
        const int s = 2 * kk + (l >> 5), n = 16 * nt + (l & 15), pp = n & 63; const f32x2v w = lp[(7 - s) * 64 + pp]; float v[8];
#pragma unroll
        for (int e = 0; e < 8; ++e) { const f32x2v pr = cmul(w, bb[pp * 16 + 8 * ((l >> 4) & 1) + e]); v[e] = n < 64 ? pr.x : pr.y; }
        u32x4 o; o.x = pk2(v[0], v[1]); o.y = pk2(v[2], v[3]); o.z = pk2(v[4], v[5]); o.w = pk2(v[6], v[7]); *(u32x4*)(tb + TB_PT + f * 16) = o; }
    for (int f = tid; f < 2048; f += 512) { const int t = f >> 8, kk = (f >> 6) & 3, l = f & 63; const int co = l & 15; float v[8];
#pragma unroll
        for (int e = 0; e < 8; ++e) { const int n = 32 * kk + 8 * (l >> 4) + e, pp = n & 63; const f32x2v d = cmul(cc[co * 64 + pp], lp[(t + 1) * 64 + pp]); v[e] = n < 64 ? d.x : -d.y; }
        u32x4 o; o.x = pk2(v[0], v[1]); o.y = pk2(v[2], v[3]); o.z = pk2(v[4], v[5]); o.w = pk2(v[6], v[7]); *(u32x4*)(tb + TB_QT + f * 16) = o; }
    __syncthreads();
    { const int D = tid >> 6, l = tid & 63, dl = D - (l >> 5), co = l & 15, c0 = 8 * ((l >> 4) & 1); float v[8];
#pragma unroll
      for (int e = 0; e < 8; ++e) v[e] = dl >= 0 ? kd[(dl * 16 + co) * 16 + c0 + e] : 0.f;
      u32x4 o; o.x = pk2(v[0], v[1]); o.y = pk2(v[2], v[3]); o.z = pk2(v[4], v[5]); o.w = pk2(v[6], v[7]); *(u32x4*)(tb + TB_KT + tid * 16) = o; }
}

__device__ __forceinline__ void unit(int g, int b, int j, const bf16_t* __restrict__ abuf, const char* __restrict__ tabs, const float* __restrict__ dsk, float* __restrict__ yf, bf16_t* __restrict__ zbuf, char* lds) {
    const int tid = ltid(), wid = __builtin_amdgcn_readfirstlane(tid >> 6), lane = tid & 63, jj = lane & 15, q = lane >> 4;
    char* hb = lds + L_HB + wid * HB_WAVE; float* et = (float*)(lds + L_ET);
    const float dco = dsk[g * 16 + jj];
#pragma unroll 1
    for (int dir = 0; dir < 2; ++dir) {
        const char* tb = tabs + (size_t)((j * 2 + dir) * NG + g) * TB_STRIDE;
        __syncthreads();
#pragma unroll
        for (int i = 0; i < 9; ++i) { const int o = (tid + i * 512) * 16; if (o < L_HB) *(u32x4*)(lds + o) = *(const u32x4*)(tb + o); }
        f32x2v a[4], wA[4], wX[4], w1[4], w2[4], w3[4];
        { const f32x2v* lp = (const f32x2v*)(tb + TB_LP);
#pragma unroll
          for (int st = 0; st < 4; ++st) { const int pp = 16 * st + jj; const f32x2v one = {1.f, 0.f}, zero = {0.f, 0.f};
              const f32x2v a1 = lp[pp], a4 = lp[64 + pp], a8 = lp[128 + pp], a12 = lp[192 + pp];
              a[st] = a1;
              wA[st] = q == 3 ? one : q == 2 ? a4 : q == 1 ? a8 : a12;
              wX[st] = q == 0 ? one : q == 1 ? a4 : q == 2 ? a8 : a12;
              { const int qq = q ^ 1, m = q - 1 - qq; w1[st] = qq < q ? (m == 0 ? one : m == 1 ? a4 : a8) : zero; }
              { const int qq = q ^ 2, m = q - 1 - qq; w2[st] = qq < q ? (m == 0 ? one : m == 1 ? a4 : a8) : zero; }
              { const int qq = q ^ 3, m = q - 1 - qq; w3[st] = qq < q ? (m == 0 ? one : m == 1 ? a4 : a8) : zero; } } }
        __syncthreads();
        for (int T_ = wid; T_ < NTILE; T_ += 8) {
            const int sgn = dir ? -1 : 1;
            const int rbase = T_ < 2 ? (dir ? NLAT + b * CTX + 255 - 128 * T_ : NLAT + b * CTX + 128 * T_) : (dir ? b * SEQ + 4095 - 128 * (T_ - 2) : b * SEQ + 128 * (T_ - 2));
            bf16x8 au[4];
#pragma unroll
            for (int kk = 0; kk < 4; ++kk) { const int row = rbase + sgn * (8 * jj + 2 * kk + (lane >> 5)); au[kk] = *(const bf16x8*)(abuf + (size_t)row * DM + g * 16 + 8 * (q & 1)); }
            f32x4 sacc[8];
#pragma unroll
            for (int nt = 0; nt < 8; ++nt) { sacc[nt] = (f32x4){0.f, 0.f, 0.f, 0.f};
#pragma unroll
                for (int kk = 0; kk < 4; ++kk) sacc[nt] = __builtin_amdgcn_mfma_f32_16x16x32_bf16(au[kk], *(const bf16x8*)(lds + L_PT + ((nt * 4 + kk) * 64 + lane) * 16), sacc[nt], 0, 0, 0); }
#pragma unroll
            for (int st = 0; st < 4; ++st) { f32x2v L = {sacc[st][0], sacc[st + 4][0]};
#pragma unroll
                for (int i = 1; i < 4; ++i) { L = cmul(a[st], L); L.x += sacc[st][i]; L.y += sacc[st + 4][i]; }
                f32x2v G = cmul(wA[st], L);
                G.x += __shfl_xor(G.x, 16); G.y += __shfl_xor(G.y, 16); G.x += __shfl_xor(G.x, 32); G.y += __shfl_xor(G.y, 32);
                if (q == 0) { et[T_ * 128 + 16 * st + jj] = G.x; et[T_ * 128 + 64 + 16 * st + jj] = G.y; } }
        }
        __syncthreads();
        if (wid == 0) { const f32x2v a128 = ((const f32x2v*)(tb + TB_LP))[256 + lane]; f32x2v X = {0.f, 0.f};
#pragma unroll 1
            for (int T_ = 0; T_ < NTILE; ++T_) { const f32x2v e = {et[T_ * 128 + lane], et[T_ * 128 + 64 + lane]}; et[T_ * 128 + lane] = X.x; et[T_ * 128 + 64 + lane] = X.y; X = cmul(a128, X); X.x += e.x; X.y += e.y; } }
        __syncthreads();
        for (int T_ = wid; T_ < NTILE; T_ += 8) {
            const int sgn = dir ? -1 : 1;
            const int rbase = T_ < 2 ? (dir ? NLAT + b * CTX + 255 - 128 * T_ : NLAT + b * CTX + 128 * T_) : (dir ? b * SEQ + 4095 - 128 * (T_ - 2) : b * SEQ + 128 * (T_ - 2));
            bf16x8 au[4];
#pragma unroll
            for (int kk = 0; kk < 4; ++kk) { const int row = rbase + sgn * (8 * jj + 2 * kk + (lane >> 5)); au[kk] = *(const bf16x8*)(abuf + (size_t)row * DM + g * 16 + 8 * (q & 1)); }
            f32x4 sacc[8];
#pragma unroll
            for (int nt = 0; nt < 8; ++nt) { sacc[nt] = (f32x4){0.f, 0.f, 0.f, 0.f};
#pragma unroll
                for (int kk = 0; kk < 4; ++kk) sacc[nt] = __builtin_amdgcn_mfma_f32_16x16x32_bf16(au[kk], *(const bf16x8*)(lds + L_PT + ((nt * 4 + kk) * 64 + lane) * 16), sacc[nt], 0, 0, 0); }
#pragma unroll
            for (int st = 0; st < 4; ++st) {
                f32x2v L = {sacc[st][0], sacc[st + 4][0]};
#pragma unroll
                for (int i = 1; i < 4; ++i) { L = cmul(a[st], L); L.x += sacc[st][i]; L.y += sacc[st + 4][i]; }
                const f32x2v G1 = {__shfl_xor(L.x, 16), __shfl_xor(L.y, 16)}, G2 = {__shfl_xor(L.x, 32), __shfl_xor(L.y, 32)}, G3 = {__shfl_xor(L.x, 48), __shfl_xor(L.y, 48)};
                const f32x2v X = {et[T_ * 128 + 16 * st + jj], et[T_ * 128 + 64 + 16 * st + jj]};
                f32x2v H = cmul(wX[st], X); { const f32x2v t1 = cmul(w1[st], G1), t2 = cmul(w2[st], G2), t3 = cmul(w3[st], G3); H.x += t1.x + t2.x + t3.x; H.y += t1.y + t2.y + t3.y; }
#pragma unroll
                for (int i = 0; i < 4; ++i) {
                    *(bf16_t*)(hb + (4 * q + i) * HB_ROW + (16 * st + jj) * 2) = f2bf(H.x); *(bf16_t*)(hb + (4 * q + i) * HB_ROW + (64 + 16 * st + jj) * 2) = f2bf(H.y);
                    H = cmul(a[st], H); H.x += sacc[st][i]; H.y += sacc[st + 4][i]; } }
            asm volatile("s_waitcnt lgkmcnt(0)" ::: "memory");
            bf16x8 ah[4];
#pragma unroll
            for (int kk = 0; kk < 4; ++kk) ah[kk] = *(const bf16x8*)(hb + jj * HB_ROW + (32 * kk + 8 * q) * 2);
            f32x4 yacc[8];
#pragma unroll
            for (int t = 0; t < 8; ++t) { yacc[t] = (f32x4){0.f, 0.f, 0.f, 0.f};
#pragma unroll
                for (int kk = 0; kk < 4; ++kk) { if (t - 2 * kk >= 0) yacc[t] = __builtin_amdgcn_mfma_f32_16x16x32_bf16(au[kk], *(const bf16x8*)(lds + L_KT + ((t - 2 * kk) * 64 + lane) * 16), yacc[t], 0, 0, 0); }
#pragma unroll
                for (int kk = 0; kk < 4; ++kk) yacc[t] = __builtin_amdgcn_mfma_f32_16x16x32_bf16(ah[kk], *(const bf16x8*)(lds + L_QT + ((t * 4 + kk) * 64 + lane) * 16), yacc[t], 0, 0, 0); }
#pragma unroll
            for (int i = 0; i < 4; ++i)
#pragma unroll
                for (int t = 0; t < 8; ++t) { const int row = rbase + sgn * (8 * (4 * q + i) + t); const size_t o = (size_t)row * DM + g * 16 + jj;
                    if (dir == 0) yf[o] = yacc[t][i];
                    else { const float v = yacc[t][i] + yf[o] + dco * bf2f(abuf[o]); zbuf[o] = f2bf(gelu_tanh(v)); } }
        }
    }
}
}

__device__ __forceinline__ void cvt_tile_fast(const float* src, int ld, int K, bf16_t* dst, int k0, int n0, float* tile  ) {
    const int tid = ltid();
    f32x4 v[8];
#pragma unroll
    for (int i = 0; i < 8; ++i) { const int idx = tid + i * 512, k = idx >> 6, c4 = idx & 63; v[i] = *(const f32x4*)(src + (size_t)(k0 + k) * ld + n0 + 4 * c4); }
#pragma unroll
    for (int i = 0; i < 8; ++i) { const int idx = tid + i * 512, k = idx >> 6, c4 = idx & 63; float* t = tile + k * 257 + 4 * c4; t[0] = v[i][0]; t[1] = v[i][1]; t[2] = v[i][2]; t[3] = v[i][3]; }
    __syncthreads();
#pragma unroll
    for (int i = 0; i < 4; ++i) { const int id = tid + i * 512, n = id >> 3, kc = (id & 7) * 8; const float* t = tile + kc * 257 + n;
        u32x4 w; w.x = pk2(t[0], t[257]); w.y = pk2(t[2 * 257], t[3 * 257]); w.z = pk2(t[4 * 257], t[5 * 257]); w.w = pk2(t[6 * 257], t[7 * 257]);
        *(u32x4*)(dst + (size_t)(n0 + n) * K + k0 + kc) = w; }
    __syncthreads();
}
__device__ __forceinline__ void cvt_tile_map(const float* src0, int ld0, const float* src1, int ld1, int K, int mode, bf16_t* dst, int k0, int n0, float* tile  ) {
    const int tid = ltid();
    { const int n = n0 + (tid & 63); const float* sp = nullptr; int ld = 0;
      if (mode == 1) { if (n < 512) { sp = src0 + n; ld = ld0; } else if (n < 1024) { sp = src1 + (n - 512); ld = ld1; } else if (n < 1088) { sp = src1 + 512 + rope_srcd(n - 1024); ld = ld1; } }
      else { const int h = n / DQK, e = n - h * DQK; sp = src0 + (e < DN ? n : h * DQK + DN + rope_srcd(e - DN)); ld = ld0; }
#pragma unroll
      for (int i = 0; i < 8; ++i) { const int k = i * 8 + (tid >> 6); tile[k * 65 + (tid & 63)] = sp ? sp[(size_t)(k0 + k) * ld] : 0.f; } }
    __syncthreads();
    { const int n = tid >> 3, kc = (tid & 7) * 8; const float* t = tile + kc * 65 + n;
      u32x4 w; w.x = pk2(t[0], t[65]); w.y = pk2(t[2 * 65], t[3 * 65]); w.z = pk2(t[4 * 65], t[5 * 65]); w.w = pk2(t[6 * 65], t[7 * 65]);
      *(u32x4*)(dst + (size_t)(n0 + n) * K + k0 + kc) = w; }
    __syncthreads();
}
__device__ __forceinline__ void ada_unit(int u, const float* ada_w, const float* ada_b, float* mod, const float* sl  , float* red  ) {
    const int tid = ltid(), w = tid >> 6, l = tid & 63, cq = l & 15, ko = l >> 4;
    const int layer = u / 192, col0 = (u % 192) * 64;
    float acc[3][4];
#pragma unroll
    for (int r = 0; r < 3; ++r)
#pragma unroll
        for (int j = 0; j < 4; ++j) acc[r][j] = 0.f;
    const float* wp = ada_w + ((size_t)layer * DM + 256 * w + ko) * (6 * DM) + col0 + 4 * cq;
#pragma unroll 8
    for (int it = 0; it < 64; ++it) { const int k = 256 * w + 4 * it + ko;
        const f32x4 wv = *(const f32x4*)(wp + (size_t)it * 4 * (6 * DM)); const f32x4 sv = *(const f32x4*)(sl + k * 4);
#pragma unroll
        for (int r = 0; r < 3; ++r)
#pragma unroll
            for (int j = 0; j < 4; ++j) acc[r][j] += sv[r] * wv[j]; }
#pragma unroll
    for (int r = 0; r < 3; ++r)
#pragma unroll
        for (int j = 0; j < 4; ++j) { float v = acc[r][j]; v += __shfl_xor(v, 16); v += __shfl_xor(v, 32); acc[r][j] = v; }
    if (ko == 0) {
#pragma unroll
        for (int r = 0; r < 3; ++r)
#pragma unroll
            for (int j = 0; j < 4; ++j) red[(w * 16 + cq) * 12 + r * 4 + j] = acc[r][j]; }
    __syncthreads();
    if (tid < 192) { const int q = tid / 12, j = tid % 12, r = j >> 2, cc = j & 3; float s = 0.f;
#pragma unroll
        for (int ww = 0; ww < 8; ++ww) s += red[(ww * 16 + q) * 12 + j];
        const int n = col0 + 4 * q + cc; s += ada_b[(size_t)layer * 6 * DM + n];
        mod[((size_t)(layer * 3 + r) * 6 + (n >> 11)) * DM + (n & (DM - 1))] = s; }
    __syncthreads();
}
__device__ __forceinline__ void misc_phase(const P& p, int gid, int nth) {
    float* rope = (float*)(p.ws + OFF_ROPE);
    for (int i = gid; i < SEQ * 32; i += nth) { const int l = i >> 5, axis = (i >> 4) & 1, f = i & 15;
        const float inv = (float)exp2(-(double)f / 16.0 * 13.287712379549449);
        const float pos = (float)(axis == 0 ? (l >> 6) : (l & 63)); const float ang = pos * inv;
        double s, c; sincos_d((double)ang, s, c); rope[(size_t)i * 2] = (float)c; rope[(size_t)i * 2 + 1] = (float)s; }
}
__device__ __forceinline__ void prologue_phase(unsigned char* lds) {
    P p;
    { KP k = kp(); p.x = k->x; p.c = k->c; p.ctx = k->ctx; p.cctx = k->cctx; p.ada_w = k->ada_w; p.ada_b = k->ada_b; p.norm1_g = k->norm1_g; p.norm2_g = k->norm2_g; p.final_g = k->final_g;
      p.lam_re = k->lam_re; p.lam_im = k->lam_im; p.log_dt = k->log_dt; p.b_re = k->b_re; p.b_im = k->b_im; p.c_re = k->c_re; p.c_im = k->c_im; p.s5_d = k->s5_d; p.w_glu = k->w_glu; p.b_glu = k->b_glu;
      p.w_dq = k->w_dq; p.q_norm = k->q_norm; p.w_uq = k->w_uq; p.w_dkv = k->w_dkv; p.kv_norm = k->kv_norm; p.w_ukv = k->w_ukv; p.w_o = k->w_o; p.ffn_w1 = k->ffn_w1; p.ffn_w2 = k->ffn_w2; p.out = k->out; p.ws = k->ws; }
    const int tid = ltid(), bid = blockIdx.x, G = gridDim.x;
    float* tile = (float*)lds;
    bf16_t* w1t = (bf16_t*)(p.ws + OFF_W1T); bf16_t* w2t = (bf16_t*)(p.ws + OFF_W2T); bf16_t* wglut = (bf16_t*)(p.ws + OFF_WGLUT); bf16_t* wot = (bf16_t*)(p.ws + OFF_WOT);
    bf16_t* wdqkvt = (bf16_t*)(p.ws + OFF_WDQKVT); bf16_t* wuqt = (bf16_t*)(p.ws + OFF_WUQT); bf16_t* wukvt = (bf16_t*)(p.ws + OFF_WUKVT);
    for (int t = bid; t < 9472; t += G) {
        const float* src; bf16_t* dst; int ld, K, kt, nt_;
        if (t < 4096) { const int i = t >> 10, r = t & 1023; src = p.ffn_w1 + (size_t)i * DM * DFF; dst = w1t + (size_t)i * DFF * DM; ld = DFF; K = DM; kt = r & 31; nt_ = r >> 5; }
        else if (t < 8192) { const int i = (t - 4096) >> 10, r = t & 1023; src = p.ffn_w2 + (size_t)i * DFF * DM; dst = w2t + (size_t)i * DM * DFF; ld = DM; K = DFF; kt = r & 127; nt_ = r >> 7; }
        else if (t < 8704) { const int j = (t - 8192) >> 8, r = t & 255; src = p.w_glu + (size_t)j * DM * DM; dst = wglut + (size_t)j * DM * DM; ld = DM; K = DM; kt = r & 31; nt_ = r >> 5; }
        else if (t < 9216) { const int j = (t - 8704) >> 8, r = t & 255; src = p.w_o + (size_t)j * DM * DM; dst = wot + (size_t)j * DM * DM; ld = DM; K = DM; kt = r & 31; nt_ = r >> 5; }
        else { const int j = (t - 9216) >> 7, r = t & 127; src = p.w_ukv + (size_t)j * KVL * 4096; dst = wukvt + (size_t)j * 4096 * KVL; ld = 4096; K = KVL; kt = r & 7; nt_ = r >> 3; }
        cvt_tile_fast(src, ld, K, dst, kt * 64, nt_ * 256, tile);
    }
    for (int t = bid; t < 2048; t += G) {
        if (t < 1280) { const int j = t / 640, r = t % 640, kt = r & 31, nt_ = r >> 5;
            cvt_tile_map(p.w_dq + (size_t)j * DM * QL, QL, p.w_dkv + (size_t)j * DM * (KVL + DR), KVL + DR, DM, 1, wdqkvt + (size_t)j * NDQKV * DM, kt * 64, nt_ * 64, tile); }
        else { const int tt = t - 1280, j = tt / 384, r = tt % 384, kt = r & 7, nt_ = r >> 3;
            cvt_tile_map(p.w_uq + (size_t)j * QL * NH * DQK, NH * DQK, nullptr, 0, QL, 2, wuqt + (size_t)j * NH * DQK * QL, kt * 64, nt_ * 64, tile); }
    }
    float* sl = (float*)lds; float* red = sl + DM * 4;
    for (int k = tid; k < DM; k += 512) { const float a = p.c[k], b = p.c[DM + k], cc = p.cctx[k];
        sl[k * 4 + 0] = a * sigmoidf_(a); sl[k * 4 + 1] = b * sigmoidf_(b); sl[k * 4 + 2] = cc * sigmoidf_(cc); sl[k * 4 + 3] = 0.f; }
    __syncthreads();
    for (int u = bid; u < 768; u += G) ada_unit(u, p.ada_w, p.ada_b, (float*)(p.ws + OFF_MOD), sl, red);
    misc_phase(p, bid * 512 + tid, G * 512);
    for (int u = bid; u < 2 * 2 * NG; u += G) s5f::make_tables(u, p, p.ws + OFF_S5T + (size_t)u * s5f::TB_STRIDE, (char*)lds);
}

__device__ __forceinline__ void norm_mod_phase(const float* xs, const float* gnorm, const float* sh, const float* sc, bf16_t* out, int M) {
    const int lane = ltid() & 63, wv = blockIdx.x * 8 + (ltid() >> 6), nw = gridDim.x * 8;
    for (int row = wv; row < M; row += nw) {
        const float* xp = xs + (size_t)row * DM; f32x4 x[8]; float ss = 0.f;
#pragma unroll
        for (int i = 0; i < 8; ++i) { x[i] = *(const f32x4*)(xp + i * 256 + lane * 4); ss += x[i][0] * x[i][0] + x[i][1] * x[i][1] + x[i][2] * x[i][2] + x[i][3] * x[i][3]; }
        ss = wave_sum(ss); const float rs = rsqrtf(ss * (1.0f / DM) + EPS); const int r = modrow(row);
#pragma unroll
        for (int i = 0; i < 8; ++i) { const int col = i * 256 + lane * 4; const f32x4 g = *(const f32x4*)(gnorm + col), a = *(const f32x4*)(sc + r * 6 * DM + col), b = *(const f32x4*)(sh + r * 6 * DM + col);
            f32x4 y = x[i] * rs * g; y = y * (1.0f + a) + b;
            u32x2 w; w.x = pk2(y[0], y[1]); w.y = pk2(y[2], y[3]); *(u32x2*)(out + (size_t)row * DM + col) = w; }
    }
}
__device__ __forceinline__ void final_norm_phase(const float* xs, const float* g, float* out) {
    const int lane = ltid() & 63, wv = blockIdx.x * 8 + (ltid() >> 6), nw = gridDim.x * 8;
    for (int row = wv; row < NLAT; row += nw) {
        const float* xp = xs + (size_t)row * DM; f32x4 x[8]; float ss = 0.f;
#pragma unroll
        for (int i = 0; i < 8; ++i) { x[i] = *(const f32x4*)(xp + i * 256 + lane * 4); ss += x[i][0] * x[i][0] + x[i][1] * x[i][1] + x[i][2] * x[i][2] + x[i][3] * x[i][3]; }
        ss = wave_sum(ss); const float rs = rsqrtf(ss * (1.0f / DM) + EPS);
#pragma unroll
        for (int i = 0; i < 8; ++i) { const int col = i * 256 + lane * 4; *(f32x4*)(out + (size_t)row * DM + col) = x[i] * rs * *(const f32x4*)(g + col); }
    }
}
__device__ __forceinline__ void mla_mid_phase(const float* qc, const float* qnorm, const float* kvnorm, const float* rope, bf16_t* qn, bf16_t* ckvn, bf16_t* kpe, int M) {
    const int lane = ltid() & 63, wv = blockIdx.x * 8 + (ltid() >> 6), nw = gridDim.x * 8;
    for (int row = wv; row < M; row += nw) {
        const float* p = qc + (size_t)row * NDQKV;
#pragma unroll
        for (int part = 0; part < 2; ++part) {
            const f32x4 a = *(const f32x4*)(p + part * 512 + lane * 8), b = *(const f32x4*)(p + part * 512 + lane * 8 + 4);
            float ss = a[0] * a[0] + a[1] * a[1] + a[2] * a[2] + a[3] * a[3] + b[0] * b[0] + b[1] * b[1] + b[2] * b[2] + b[3] * b[3];
            ss = wave_sum(ss); const float rs = rsqrtf(ss * (1.0f / 512) + EPS);
            const float* gn = (part ? kvnorm : qnorm) + lane * 8; const f32x4 g0 = *(const f32x4*)gn, g1 = *(const f32x4*)(gn + 4);
            const f32x4 y0 = a * rs * g0, y1 = b * rs * g1;
            u32x4 w; w.x = pk2(y0[0], y0[1]); w.y = pk2(y0[2], y0[3]); w.z = pk2(y1[0], y1[1]); w.w = pk2(y1[2], y1[3]);
            *(u32x4*)((part ? ckvn : qn) + (size_t)row * 512 + lane * 8) = w; }
        int bb, key, lpos; row_bk(row, bb, key, lpos);
        float v = p[1024 + lane]; const float other = __shfl_xor(v, 1);
        if (lpos >= 0) { const int axis = lane >> 5, f = (lane & 31) >> 1; const float cs = rope[((size_t)(lpos * 2 + axis) * 16 + f) * 2], sn = rope[((size_t)(lpos * 2 + axis) * 16 + f) * 2 + 1];
            v = (lane & 1) ? (other * sn + v * cs) : (v * cs - other * sn); }
        kpe[((size_t)bb * NKEY + key) * DR + lane] = f2bf(v);
    }
}

namespace att {
typedef float f32x16 __attribute__((ext_vector_type(16)));
typedef short s16x4 __attribute__((ext_vector_type(4)));
constexpr int KVBLK = 64;
constexpr int SHM_V = KVBLK * 128 * 2, SHM_K = KVBLK * 128 * 2, SHM_P = KVBLK * 64 * 2;
constexpr int OFF_V = 0, OFF_KN = 2 * SHM_V, OFF_KP = OFF_KN + 2 * SHM_K, OFF_WS = OFF_KP + 2 * SHM_P, LDS_ATT = OFF_WS + 8 * 64 * 4;
constexpr int OST_STRIDE = 320, OST_WAVE = 32 * OST_STRIDE;
constexpr float THR2 = 11.5f;
#define ATT_KSWZ(row, colB) ((row) * 256 + ((colB) ^ (((row) & 7) << 4)))
#define ATT_PSWZ(row, colB) ((row) * 128 + ((colB) ^ ((((row) >> 1) & 7) << 4)))
#define ATT_SBAR() __builtin_amdgcn_sched_barrier(0)
__device__ __forceinline__ int crow(int r, int hi) { return (r & 3) + 8 * (r >> 2) + 4 * hi; }
__device__ __forceinline__ unsigned cvtpk(float lo, float hi) { unsigned r; asm volatile("v_cvt_pk_bf16_f32 %0, %1, %2" : "=v"(r) : "v"(lo), "v"(hi)); return r; }
__device__ __forceinline__ void partialSM(f32x16& p0, f32x16& p1, float& m_reg, float& mn, float& alpha) {
    float pmax = p0[0];
#pragma unroll
    for (int r = 1; r < 16; ++r) pmax = fmaxf(pmax, p0[r]);
#pragma unroll
    for (int r = 0; r < 16; ++r) pmax = fmaxf(pmax, p1[r]);
    { auto rr = __builtin_amdgcn_permlane32_swap(__float_as_uint(pmax), __float_as_uint(pmax), false, false);
      pmax = fmaxf(__uint_as_float(rr[0]), __uint_as_float(rr[1])); }
    if (__builtin_expect(__all(pmax - m_reg <= THR2), 1)) { mn = m_reg; alpha = 1.f; }
    else { mn = fmaxf(m_reg, pmax); alpha = __builtin_amdgcn_exp2f(m_reg - mn); m_reg = mn; }
#pragma unroll
    for (int r = 0; r < 16; ++r) p0[r] = p0[r] - mn;
#pragma unroll
    for (int r = 0; r < 16; ++r) p1[r] = p1[r] - mn;
#pragma unroll
    for (int r = 0; r < 16; ++r) p0[r] = __builtin_amdgcn_exp2f(p0[r]);
}
__device__ __forceinline__ void finishSM(f32x16& p0, f32x16& p1, float alpha, float& l_reg, bf16x8& pa0, bf16x8& pa1, bf16x8& pa2, bf16x8& pa3) {
#pragma unroll
    for (int r = 0; r < 16; ++r) p1[r] = __builtin_amdgcn_exp2f(p1[r]);
    float ps = 0;
#pragma unroll
    for (int r = 0; r < 16; ++r) ps += p0[r];
#pragma unroll
    for (int r = 0; r < 16; ++r) ps += p1[r];
    { auto rr = __builtin_amdgcn_permlane32_swap(__float_as_uint(ps), __float_as_uint(ps), false, false);
      ps = __uint_as_float(rr[0]) + __uint_as_float(rr[1]); }
    l_reg = l_reg * alpha + ps;
#define ATT_PK4(P, BASE, OUT) do { unsigned a0 = cvtpk(P[BASE + 0], P[BASE + 1]), a1 = cvtpk(P[BASE + 2], P[BASE + 3]);   \
    unsigned b0 = cvtpk(P[BASE + 4], P[BASE + 5]), b1 = cvtpk(P[BASE + 6], P[BASE + 7]);                              \
    auto r0 = __builtin_amdgcn_permlane32_swap(a0, b0, false, false); auto r1 = __builtin_amdgcn_permlane32_swap(a1, b1, false, false); \
    u32x4 w = {r0[0], r1[0], r0[1], r1[1]}; OUT = *reinterpret_cast<bf16x8*>(&w); } while (0)
    ATT_PK4(p0, 0, pa0); ATT_PK4(p0, 8, pa1); ATT_PK4(p1, 0, pa2); ATT_PK4(p1, 8, pa3);
#undef ATT_PK4
}
__device__ __forceinline__ void qkt(f32x16& p0, f32x16& p1, const char* Kn, const char* Kp, const bf16x8* qr, int r32, int hi) {
    p0 = f32x16{}; p1 = f32x16{};
#pragma unroll
    for (int d0 = 0; d0 < 8; ++d0) { const int cb = (d0 * 16 + hi * 8) * 2;
        const bf16x8 b0 = *reinterpret_cast<const bf16x8*>(Kn + ATT_KSWZ(r32, cb));
        const bf16x8 b1 = *reinterpret_cast<const bf16x8*>(Kn + ATT_KSWZ(32 + r32, cb));
        p0 = __builtin_amdgcn_mfma_f32_32x32x16_bf16(b0, qr[d0], p0, 0, 0, 0);
        p1 = __builtin_amdgcn_mfma_f32_32x32x16_bf16(b1, qr[d0], p1, 0, 0, 0); }
#pragma unroll
    for (int d0 = 0; d0 < 4; ++d0) { const int cb = (d0 * 16 + hi * 8) * 2;
        const bf16x8 b0 = *reinterpret_cast<const bf16x8*>(Kp + ATT_PSWZ(r32, cb));
        const bf16x8 b1 = *reinterpret_cast<const bf16x8*>(Kp + ATT_PSWZ(32 + r32, cb));
        p0 = __builtin_amdgcn_mfma_f32_32x32x16_bf16(b0, qr[8 + d0], p0, 0, 0, 0);
        p1 = __builtin_amdgcn_mfma_f32_32x32x16_bf16(b1, qr[8 + d0], p1, 0, 0, 0); }
}
__device__ __forceinline__ int v_st(int k, int c) { const int kk = (k & ~0xC) | ((k & 4) << 1) | ((k & 8) >> 1); return ((kk >> 3) * 4 + (c >> 5)) * 512 + ((kk & 7) * 32 + (c & 31)) * 2; }
__device__ __forceinline__ int v_rd_base(int lane) { return ((lane & 3) << 3) | (((lane >> 2) & 3) << 6) | (((lane >> 4) & 1) << 5) | (((lane >> 5) & 1) << 8); }
constexpr int v_rd_off(int d0, int ks, int half) { return d0 * 512 + ks * 4096 + half * 2048; }
template <int OFF> __device__ __forceinline__ s16x4 tr_read(int vb) { s16x4 r; asm volatile("ds_read_b64_tr_b16 %0, %1 offset:%2" : "=&v"(r) : "v"(vb), "i"(OFF) : "memory"); return r; }
template <int D0> __device__ __forceinline__ void pv_one(f32x16& od, int vb, bf16x8 pa0, bf16x8 pa1, bf16x8 pa2, bf16x8 pa3) {
    const s16x4 l0 = tr_read<v_rd_off(D0, 0, 0)>(vb), h0 = tr_read<v_rd_off(D0, 0, 1)>(vb), l1 = tr_read<v_rd_off(D0, 1, 0)>(vb), h1 = tr_read<v_rd_off(D0, 1, 1)>(vb);
    const s16x4 l2 = tr_read<v_rd_off(D0, 2, 0)>(vb), h2 = tr_read<v_rd_off(D0, 2, 1)>(vb), l3 = tr_read<v_rd_off(D0, 3, 0)>(vb), h3 = tr_read<v_rd_off(D0, 3, 1)>(vb);
    asm volatile("s_waitcnt lgkmcnt(0)" ::: "memory"); ATT_SBAR();
#define ATT_PK(L, H) (bf16x8){L[0], L[1], L[2], L[3], H[0], H[1], H[2], H[3]}
    od = __builtin_amdgcn_mfma_f32_32x32x16_bf16(pa0, ATT_PK(l0, h0), od, 0, 0, 0);
    od = __builtin_amdgcn_mfma_f32_32x32x16_bf16(pa1, ATT_PK(l1, h1), od, 0, 0, 0);
    od = __builtin_amdgcn_mfma_f32_32x32x16_bf16(pa2, ATT_PK(l2, h2), od, 0, 0, 0);
    od = __builtin_amdgcn_mfma_f32_32x32x16_bf16(pa3, ATT_PK(l3, h3), od, 0, 0, 0);
#undef ATT_PK
}
__device__ __forceinline__ void pv_d0(f32x16* o, int vb, bf16x8 pa0, bf16x8 pa1, bf16x8 pa2, bf16x8 pa3) {
    pv_one<0>(o[0], vb, pa0, pa1, pa2, pa3); pv_one<1>(o[1], vb, pa0, pa1, pa2, pa3); pv_one<2>(o[2], vb, pa0, pa1, pa2, pa3); pv_one<3>(o[3], vb, pa0, pa1, pa2, pa3);
}
__device__ __forceinline__ void attn_unit(const bf16_t* __restrict__ Qb, const bf16_t* __restrict__ Kh, const bf16_t* __restrict__ Ph, const bf16_t* __restrict__ Vh, bf16_t* __restrict__ Ob, int NT, char* lds) {
    const int tid = ltid(), wid = tid >> 6, lane = tid & 63, r32 = lane & 31, hi = lane >> 5;
    char* V_lds = lds + OFF_V; char* K_lds = lds + OFF_KN; char* P_lds = lds + OFF_KP;
    float* wsl = (float*)(lds + OFF_WS) + wid * 64; float* li_l = wsl; float* al_l = wsl + 32;
    float m_reg = -1e30f, l_reg = 0; f32x16 o[4] = {}; bf16x8 qr[12];
    const bf16_t* Qw = Qb + (size_t)(wid * 32 + r32) * DQK + hi * 8;
#pragma unroll
    for (int d0 = 0; d0 < 12; ++d0) qr[d0] = *reinterpret_cast<const bf16x8*>(Qw + d0 * 16);
    const int sr = tid >> 4, sc = (tid & 15) * 8, vst0 = v_st(sr, sc), vst1 = v_st(32 + sr, sc);
    const int pr_ = tid >> 3, pc = (tid & 7) * 16;
    const int vb0 = (int)(uintptr_t)(LAS char*)V_lds + v_rd_base(lane);
    bf16x8 vs0, vs1, ks0, ks1, ps0;
#define ATT_SLOAD(k0) do { vs0 = *reinterpret_cast<const bf16x8*>(&Vh[(size_t)((k0) + sr) * 128 + sc]); vs1 = *reinterpret_cast<const bf16x8*>(&Vh[(size_t)((k0) + 32 + sr) * 128 + sc]); \
    ks0 = *reinterpret_cast<const bf16x8*>(&Kh[(size_t)((k0) + sr) * 128 + sc]); ks1 = *reinterpret_cast<const bf16x8*>(&Kh[(size_t)((k0) + 32 + sr) * 128 + sc]); \
    ps0 = *reinterpret_cast<const bf16x8*>(&Ph[(size_t)((k0) + pr_) * 64 + (pc >> 1)]); } while (0)
#define ATT_SWRITE(b) do { *(bf16x8*)(V_lds + (b) * SHM_V + vst0) = vs0; *(bf16x8*)(V_lds + (b) * SHM_V + vst1) = vs1; const int kc = sc * 2;   \
    *(bf16x8*)(K_lds + (b) * SHM_K + ATT_KSWZ(sr, kc)) = ks0; *(bf16x8*)(K_lds + (b) * SHM_K + ATT_KSWZ(32 + sr, kc)) = ks1;                    \
    *(bf16x8*)(P_lds + (b) * SHM_P + ATT_PSWZ(pr_, pc)) = ps0; } while (0)
#define ATT_SWAIT() asm volatile("s_waitcnt vmcnt(0)" ::: "memory")
#define ATT_RESC(a) do { if (__any((a) < 1.f)) { if (hi == 0) al_l[r32] = (a); asm volatile("s_waitcnt lgkmcnt(0)" ::: "memory"); \
    _Pragma("unroll") for (int d = 0; d < 4; ++d) _Pragma("unroll") for (int r = 0; r < 16; ++r) o[d][r] *= al_l[crow(r, hi)]; } } while (0)
    f32x16 pA0, pA1, pB0, pB1; float mnA, mnB, alA, alB; bf16x8 pa0, pa1, pa2, pa3;
    ATT_SLOAD(0); ATT_SWAIT(); ATT_SWRITE(0); __syncthreads();
    qkt(pA0, pA1, K_lds, P_lds, qr, r32, hi); partialSM(pA0, pA1, m_reg, mnA, alA);
    ATT_SLOAD(KVBLK);
    ATT_SWAIT(); ATT_SWRITE(1); __syncthreads();
    for (int j = 1; j + 1 < NT; j += 2) {
        ATT_SBAR(); qkt(pB0, pB1, K_lds + SHM_K, P_lds + SHM_P, qr, r32, hi);
        finishSM(pA0, pA1, alA, l_reg, pa0, pa1, pa2, pa3); ATT_SBAR();
        ATT_SLOAD((j + 1) * KVBLK); ATT_SBAR();
        pv_d0(o, vb0, pa0, pa1, pa2, pa3); partialSM(pB0, pB1, m_reg, mnB, alB);
        __syncthreads(); ATT_SWAIT(); ATT_SWRITE(0);
        ATT_RESC(alB); __syncthreads();
        ATT_SBAR(); qkt(pA0, pA1, K_lds, P_lds, qr, r32, hi);
        finishSM(pB0, pB1, alB, l_reg, pa0, pa1, pa2, pa3); ATT_SBAR();
        ATT_SLOAD((j + 2) * KVBLK); ATT_SBAR();
        pv_d0(o, vb0 + SHM_V, pa0, pa1, pa2, pa3); partialSM(pA0, pA1, m_reg, mnA, alA);
        __syncthreads(); ATT_SWAIT(); ATT_SWRITE(1);
        ATT_RESC(alA); __syncthreads();
    }
    ATT_SBAR(); qkt(pB0, pB1, K_lds + SHM_K, P_lds + SHM_P, qr, r32, hi);
    finishSM(pA0, pA1, alA, l_reg, pa0, pa1, pa2, pa3); ATT_SBAR();
    pv_d0(o, vb0, pa0, pa1, pa2, pa3); partialSM(pB0, pB1, m_reg, mnB, alB);
    __syncthreads(); ATT_RESC(alB);
    finishSM(pB0, pB1, alB, l_reg, pa0, pa1, pa2, pa3); ATT_SBAR();
    pv_d0(o, vb0 + SHM_V, pa0, pa1, pa2, pa3);
    if (hi == 0) li_l[r32] = l_reg; asm volatile("s_waitcnt lgkmcnt(0)" ::: "memory");
    float rli[16];
#pragma unroll
    for (int r = 0; r < 16; ++r) rli[r] = __builtin_amdgcn_rcpf(li_l[crow(r, hi)]);
    __syncthreads();
    char* ost = lds + wid * OST_WAVE; const int odd = lane & 1;
#pragma unroll
    for (int d0 = 0; d0 < 4; ++d0)
#pragma unroll
        for (int r = 0; r < 16; r += 2) {
            const float ve = o[d0][r] * rli[r], vo = o[d0][r + 1] * rli[r + 1];
            const float recv = __shfl_xor(odd ? ve : vo, 1);
            const float lo = odd ? recv : ve, hh = odd ? vo : recv;
            const int row = crow(odd ? r + 1 : r, hi);
            *(unsigned*)(ost + row * OST_STRIDE + (32 * d0 + (r32 & ~1)) * 2) = cvtpk(lo, hh);
        }
    asm volatile("s_waitcnt lgkmcnt(0)" ::: "memory");
#pragma unroll
    for (int i = 0; i < 8; ++i) { const int id = lane + 64 * i, row = id >> 4, ch = id & 15;
        const u32x4 w = *(const u32x4*)(ost + row * OST_STRIDE + ch * 16);
        *(u32x4*)(Ob + (size_t)(wid * 32 + row) * DM + ch * 8) = w; }
    __syncthreads();
#undef ATT_SLOAD
#undef ATT_SWRITE
#undef ATT_SWAIT
#undef ATT_RESC
}
__device__ __forceinline__ void attn_phase(const bf16_t* Q, const bf16_t* K, const bf16_t* Kpe, const bf16_t* V, bf16_t* out, bool with_ctx, char* lds) {
    const int nu = 512 + (with_ctx ? 32 : 0);
    for (int u = blockIdx.x; u < nu; u += gridDim.x) {
        if (u < 512) { int bh = u >> 4, qb = u & 15;
            if (gridDim.x == 256) { const int c = u & 255, rnd = u >> 8, idx = c >> 3; bh = rnd * 16 + (c & 7) * 2 + (idx >> 4); qb = idx & 15; }
            const int b = bh >> 4, h = bh & 15;
            attn_unit(Q + ((size_t)bh * NKEY + CTX + qb * 256) * DQK, K + (size_t)bh * NKEY * DN, Kpe + (size_t)b * NKEY * DR, V + (size_t)bh * NKEY * DV,
                      out + (size_t)(b * SEQ + qb * 256) * DM + h * DV, NKEY / KVBLK, lds); }
        else { const int bh = u - 512, b = bh >> 4, h = bh & 15;
            attn_unit(Q + (size_t)bh * NKEY * DQK, K + (size_t)bh * NKEY * DN, Kpe + (size_t)b * NKEY * DR, V + (size_t)bh * NKEY * DV,
                      out + (size_t)(NLAT + b * CTX) * DM + h * DV, CTX / KVBLK, lds); }
    }
}
}

template <class Epi> __device__ __forceinline__ void gemm_call(unsigned char* lds, const bf16_t* A, const bf16_t* Bt, int M, int N, int K, const Epi& E) {
    pg8::Gemm g; g.A = A; g.Bt = Bt; g.M = M; g.N = N; g.K = K;
    pg8::StaticOrder S; S.init(M, N, (int)gridDim.x, (int)blockIdx.x);
    pg8::gemm_phase<Epi, pg8::StaticOrder>((LAS unsigned char*)lds, g, S, E);
}
template <int PR> __device__ __forceinline__ void layer_pair(unsigned char* shm, const XcdBarrier& bar) {
#define GSYNC() xcd_barrier(bar)
#define MODL(k, i) ((const float*)((k)->ws + OFF_MOD) + (size_t)(i) * 3 * 6 * DM)
    const float qscale = 0.07216878364870322f * 1.4426950408889634f;
    { constexpr int i = 2 * PR, j = PR;
      { KP k = kp(); char* ws = k->ws; const float* modl = MODL(k, i);
        norm_mod_phase((const float*)(ws + OFF_XS), k->norm1_g + (size_t)i * DM, modl + 0 * DM, modl + 1 * DM, (bf16_t*)(ws + OFF_ABUF), MROWS); }
      GSYNC();
      { KP k = kp(); char* ws = k->ws;
        for (int u = blockIdx.x; u < NG * NB; u += gridDim.x) s5f::unit(u >> 1, u & 1, j, (const bf16_t*)(ws + OFF_ABUF), ws + OFF_S5T, k->s5_d + (size_t)j * DM, (float*)(ws + OFF_YF), (bf16_t*)(ws + OFF_ZBUF), (char*)shm); }
      GSYNC();
      { KP k = kp(); char* ws = k->ws; Epi4<FGlu> e; e.f.xs = (float*)(ws + OFF_XS); e.f.g = MODL(k, i) + 2 * DM; e.f.z = (const bf16_t*)(ws + OFF_ZBUF); e.f.bglu = k->b_glu + (size_t)j * DM;
        gemm_call(shm, (const bf16_t*)(ws + OFF_ZBUF), (const bf16_t*)(ws + OFF_WGLUT) + (size_t)j * DM * DM, MROWS, DM, DM, e); }
      GSYNC();
      { KP k = kp(); char* ws = k->ws; const float* modl = MODL(k, i);
        norm_mod_phase((const float*)(ws + OFF_XS), k->norm2_g + (size_t)i * DM, modl + 3 * DM, modl + 4 * DM, (bf16_t*)(ws + OFF_ABUF), MROWS); }
      GSYNC();
      { KP k = kp(); char* ws = k->ws; Epi8<FUp> e; e.f.h = (bf16_t*)(ws + OFF_HBUF); gemm_call(shm, (const bf16_t*)(ws + OFF_ABUF), (const bf16_t*)(ws + OFF_W1T) + (size_t)i * DFF * DM, MROWS, DFF, DM, e); }
      GSYNC();
      { KP k = kp(); char* ws = k->ws; Epi4<FRes> e; e.f.xs = (float*)(ws + OFF_XS); e.f.g = MODL(k, i) + 5 * DM; gemm_call(shm, (const bf16_t*)(ws + OFF_HBUF), (const bf16_t*)(ws + OFF_W2T) + (size_t)i * DM * DFF, MROWS, DM, DFF, e); }
      GSYNC();
    }
    { constexpr int i = 2 * PR + 1, j = PR; constexpr bool last = (i == DEPTH - 1); constexpr int M = last ? NLAT : MROWS;
      { KP k = kp(); char* ws = k->ws; const float* modl = MODL(k, i);
        norm_mod_phase((const float*)(ws + OFF_XS), k->norm1_g + (size_t)i * DM, modl + 0 * DM, modl + 1 * DM, (bf16_t*)(ws + OFF_ABUF), MROWS); }
      GSYNC();
      { KP k = kp(); char* ws = k->ws; Epi4<FF32> e; e.f.C = (float*)(ws + OFF_QC); e.f.ldc = NDQKV; gemm_call(shm, (const bf16_t*)(ws + OFF_ABUF), (const bf16_t*)(ws + OFF_WDQKVT) + (size_t)j * NDQKV * DM, MROWS, NDQKV, DM, e); }
      GSYNC();
      { KP k = kp(); char* ws = k->ws;
        mla_mid_phase((const float*)(ws + OFF_QC), k->q_norm + (size_t)j * QL, k->kv_norm + (size_t)j * KVL, (const float*)(ws + OFF_ROPE), (bf16_t*)(ws + OFF_QN), (bf16_t*)(ws + OFF_CKVN), (bf16_t*)(ws + OFF_KPE), MROWS); }
      GSYNC();
      { KP k = kp(); char* ws = k->ws; Epi8<FUq> e; e.f.Q = (bf16_t*)(ws + OFF_Q); e.f.rope = (const float*)(ws + OFF_ROPE); e.f.qscale = qscale;
        gemm_call(shm, (const bf16_t*)(ws + OFF_QN), (const bf16_t*)(ws + OFF_WUQT) + (size_t)j * NH * DQK * QL, M, NH * DQK, QL, e); }
      { KP k = kp(); char* ws = k->ws; Epi8<FUkv> e; e.f.Kb = (bf16_t*)(ws + OFF_K); e.f.Vb = (bf16_t*)(ws + OFF_V);
        gemm_call(shm, (const bf16_t*)(ws + OFF_CKVN), (const bf16_t*)(ws + OFF_WUKVT) + (size_t)j * NH * (DN + DV) * KVL, MROWS, NH * (DN + DV), KVL, e); }
      GSYNC();
      { KP k = kp(); char* ws = k->ws;
        att::attn_phase((const bf16_t*)(ws + OFF_Q), (const bf16_t*)(ws + OFF_K), (const bf16_t*)(ws + OFF_KPE), (const bf16_t*)(ws + OFF_V), (bf16_t*)(ws + OFF_ABUF), !last, (char*)shm); }
      GSYNC();
      { KP k = kp(); char* ws = k->ws; Epi4<FRes> e; e.f.xs = (float*)(ws + OFF_XS); e.f.g = MODL(k, i) + 2 * DM; gemm_call(shm, (const bf16_t*)(ws + OFF_ABUF), (const bf16_t*)(ws + OFF_WOT) + (size_t)j * DM * DM, M, DM, DM, e); }
      GSYNC();
      { KP k = kp(); char* ws = k->ws; const float* modl = MODL(k, i);
        norm_mod_phase((const float*)(ws + OFF_XS), k->norm2_g + (size_t)i * DM, modl + 3 * DM, modl + 4 * DM, (bf16_t*)(ws + OFF_ABUF), M); }
      GSYNC();
      { KP k = kp(); char* ws = k->ws; Epi8<FUp> e; e.f.h = (bf16_t*)(ws + OFF_HBUF); gemm_call(shm, (const bf16_t*)(ws + OFF_ABUF), (const bf16_t*)(ws + OFF_W1T) + (size_t)i * DFF * DM, M, DFF, DM, e); }
      GSYNC();
      { KP k = kp(); char* ws = k->ws; Epi4<FRes> e; e.f.xs = (float*)(ws + OFF_XS); e.f.g = MODL(k, i) + 5 * DM; gemm_call(shm, (const bf16_t*)(ws + OFF_HBUF), (const bf16_t*)(ws + OFF_W2T) + (size_t)i * DM * DFF, M, DM, DFF, e); }
      GSYNC();
    }
#undef GSYNC
#undef MODL
}
__global__ void __launch_bounds__(512, 2) mega(P p_unused) {
    extern __shared__ __attribute__((aligned(16))) unsigned char shm[];
    if (threadIdx.x < 4) ((unsigned*)(shm + LDS_CTL))[threadIdx.x] = 0u;
    __syncthreads();
    XcdBarrier bar = xcd_barrier_post((unsigned*)(kp()->ws + OFF_BAR), (volatile LAS unsigned*)(shm + LDS_CTL));
    prologue_phase(shm);
    xcd_barrier(bar);
    layer_pair<0>(shm, bar);
    layer_pair<1>(shm, bar);
    { KP k = kp(); final_norm_phase((const float*)(k->ws + OFF_XS), k->final_g, k->out); }
}

extern "C" void kernel_launch(void* const* d_in, const int* in_sizes, int n_in, void* d_out, int out_size, void* d_ws, size_t ws_size, hipStream_t stream) {
    if (n_in != 28 || ws_size < WS_END) { fprintf(stderr, "kernel_launch: unexpected inputs (%d) or workspace (%zu < %zu)\n", n_in, ws_size, (size_t)WS_END); return; }
    static int grid = 0;
    if (!grid) {
        int dev = 0, cus = 0, per_cu = 0;
        (void)hipGetDevice(&dev); (void)hipDeviceGetAttribute(&cus, hipDeviceAttributeMultiprocessorCount, dev);
        if (hipFuncSetAttribute((const void*)mega, hipFuncAttributeMaxDynamicSharedMemorySize, LDS_BYTES) != hipSuccess) { fprintf(stderr, "kernel_launch: hipFuncSetAttribute failed\n"); return; }
        if (hipOccupancyMaxActiveBlocksPerMultiprocessor(&per_cu, (const void*)mega, 512, LDS_BYTES) != hipSuccess || per_cu < 1) fprintf(stderr, "kernel_launch: occupancy query says %d blocks per CU\n", per_cu);
        grid = cus > 0 ? cus : 256;
    }
    P p; memset(&p, 0, sizeof(p));
    const float** fp = (const float**)&p;
    for (int i = 0; i < 28; ++i) fp[i] = (const float*)d_in[i];
    p.out = (float*)d_out; p.ws = (char*)d_ws;
    float* xs = (float*)(p.ws + OFF_XS);
    (void)hipMemsetAsync(p.ws + OFF_BAR, 0, XCD_BAR_WORDS * sizeof(unsigned), stream);
    (void)hipMemcpyAsync(xs, p.x, (size_t)NLAT * DM * 4, hipMemcpyDeviceToDevice, stream);
    (void)hipMemcpyAsync(xs + (size_t)NLAT * DM, p.ctx, (size_t)NCTX * DM * 4, hipMemcpyDeviceToDevice, stream);
    hipLaunchKernelGGL(mega, dim3(grid), dim3(512), LDS_BYTES, stream, p);
    const hipError_t le = hipPeekAtLastError();
    if (le != hipSuccess) fprintf(stderr, "kernel_launch: launch failed: %s\n", hipGetErrorName(le));
}
```

```cpp
#include <hip/hip_runtime.h>
#ifndef PROBE
#define PROBE 0
#endif
#include <stdint.h>
#include <cstdio>
#include <cstring>

#define LAS __attribute__((address_space(3)))
typedef unsigned short bf16_t;
typedef short bf16x8 __attribute__((ext_vector_type(8)));
typedef float f32x4 __attribute__((ext_vector_type(4)));
typedef float f32x2 __attribute__((ext_vector_type(2)));
typedef unsigned u32x4 __attribute__((ext_vector_type(4)));
typedef unsigned u32x2 __attribute__((ext_vector_type(2)));

constexpr int DM = 2048, NB = 2, SEQ = 4096, CTX = 256, DEPTH = 4, DFF = 8192;
constexpr int NLAT = NB * SEQ, NCTX = NB * CTX, MROWS = NLAT + NCTX;
constexpr int NKEY = CTX + SEQ;
constexpr int NG = 128, NP = 64, GC = 16;
constexpr int NH = 16, QL = 512, KVL = 512, DN = 128, DR = 64, DV = 128, DQK = DN + DR;
constexpr int NDQKV = 1280;
constexpr float EPS = 1e-6f;

constexpr size_t al256(size_t x) { return (x + 255) & ~(size_t)255; }
constexpr size_t OFF_BAR = 0;
constexpr size_t OFF_MOD = 16384;
constexpr size_t OFF_ROPE = OFF_MOD + al256((size_t)DEPTH * 3 * 6 * DM * 4);
constexpr size_t OFF_LAMB = OFF_ROPE + al256((size_t)SEQ * 2 * 16 * 2 * 4);
constexpr size_t OFF_BBAR = OFF_LAMB + al256((size_t)2 * 2 * NG * NP * 2 * 4);
constexpr size_t OFF_XS = OFF_BBAR + al256((size_t)2 * 2 * NG * NP * GC * 2 * 4);
constexpr size_t OFF_ABUF = OFF_XS + al256((size_t)MROWS * DM * 4);
constexpr size_t OFF_ZBUF = OFF_ABUF + al256((size_t)MROWS * DM * 2);
constexpr size_t OFF_HBUF = OFF_ZBUF + al256((size_t)MROWS * DM * 2);
constexpr size_t OFF_YF = OFF_HBUF + al256((size_t)MROWS * DFF * 2);
constexpr size_t OFF_YB = OFF_YF + al256((size_t)MROWS * DM * 4);
constexpr size_t OFF_S5T = OFF_YB;
constexpr size_t OFF_QC = OFF_YB + al256((size_t)MROWS * DM * 4);
constexpr size_t OFF_QN = OFF_QC + al256((size_t)MROWS * NDQKV * 4);
constexpr size_t OFF_CKVN = OFF_QN + al256((size_t)MROWS * QL * 2);
constexpr size_t OFF_KPE = OFF_CKVN + al256((size_t)MROWS * KVL * 2);
constexpr size_t OFF_Q = OFF_KPE + al256((size_t)NB * NKEY * DR * 2);
constexpr size_t OFF_K = OFF_Q + al256((size_t)NB * NH * NKEY * DQK * 2);
constexpr size_t OFF_V = OFF_K + al256((size_t)NB * NH * NKEY * DN * 2);
constexpr size_t OFF_W1T = OFF_V + al256((size_t)NB * NH * NKEY * DV * 2);
constexpr size_t OFF_W2T = OFF_W1T + (size_t)DEPTH * DFF * DM * 2;
constexpr size_t OFF_WGLUT = OFF_W2T + (size_t)DEPTH * DFF * DM * 2;
constexpr size_t OFF_WOT = OFF_WGLUT + (size_t)2 * DM * DM * 2;
constexpr size_t OFF_WDQKVT = OFF_WOT + (size_t)2 * DM * DM * 2;
constexpr size_t OFF_WUQT = OFF_WDQKVT + (size_t)2 * NDQKV * DM * 2;
constexpr size_t OFF_WUKVT = OFF_WUQT + (size_t)2 * NH * DQK * QL * 2;
constexpr size_t WS_END = OFF_WUKVT + (size_t)2 * NH * (DN + DV) * KVL * 2;

__device__ __forceinline__ float bf2f(bf16_t b) { return __uint_as_float(((unsigned)b) << 16); }
__device__ __forceinline__ bf16_t f2bf(float f) { unsigned u = __float_as_uint(f); u += 0x7FFFu + ((u >> 16) & 1u); return (bf16_t)(u >> 16); }
__device__ __forceinline__ unsigned pk2(float lo, float hi) { return (unsigned)f2bf(lo) | ((unsigned)f2bf(hi) << 16); }
__device__ __forceinline__ float wave_sum(float v) {
#pragma unroll
    for (int o = 32; o >= 1; o >>= 1) v += __shfl_xor(v, o);
    return v;
}
__device__ __forceinline__ float sigmoidf_(float x) { return 1.0f / (1.0f + __expf(-x)); }
__device__ __forceinline__ float gelu_tanh(float x) { const float u2 = 1.5957691216057308f * (x + 0.044715f * x * x * x); return x * __builtin_amdgcn_rcpf(1.0f + __expf(-u2)); }
__device__ __forceinline__ void sincos_d(double a, double& s, double& c) {
    const double kd = rint(a * 0.63661977236758134308);
    double r = fma(-kd, 1.57079632679489655800e+00, a); r = fma(-kd, 6.12323399573676603587e-17, r);
    const long long k = (long long)kd; const double r2 = r * r;
    const double sp = r * (1.0 + r2 * (-1.0 / 6 + r2 * (1.0 / 120 + r2 * (-1.0 / 5040 + r2 * (1.0 / 362880 + r2 * (-1.0 / 39916800 + r2 * (1.0 / 6227020800.0)))))));
    const double cp = 1.0 + r2 * (-0.5 + r2 * (1.0 / 24 + r2 * (-1.0 / 720 + r2 * (1.0 / 40320 + r2 * (-1.0 / 3628800 + r2 * (1.0 / 479001600.0 + r2 * (-1.0 / 87178291200.0)))))));
    const int q = (int)(k & 3);
    s = (q == 0) ? sp : (q == 1) ? cp : (q == 2) ? -sp : -cp;
    c = (q == 0) ? cp : (q == 1) ? -sp : (q == 2) ? -cp : sp;
}
__device__ __forceinline__ int rope_srcd(int dp) { return (dp & 32) + (dp & 1) * 16 + ((dp & 31) >> 1); }

constexpr int LDS_WTAB = 163840 - 16 - 256;
extern __shared__ __attribute__((aligned(16))) unsigned char dyn_lds_base[];
__device__ __forceinline__ int lbid() { int b = (int)blockIdx.x; asm volatile("" : "+s"(b)); return b; }
__device__ __forceinline__ int lgrid() { int g = (int)gridDim.x; asm volatile("" : "+s"(g)); return g; }
__device__ __forceinline__ int hw_slot() { return (int)(__builtin_amdgcn_s_getreg((5 << 11) | 4) & 63u); }
__device__ __forceinline__ void ltid_setup() { if ((threadIdx.x & 63) == 0) ((LAS int*)(LAS unsigned char*)dyn_lds_base + LDS_WTAB / 4)[hw_slot()] = (int)threadIdx.x >> 6; }
__device__ __forceinline__ int ltid() {
    const int w = __builtin_amdgcn_readfirstlane(((volatile LAS int*)(LAS unsigned char*)dyn_lds_base + LDS_WTAB / 4)[hw_slot()]);
    int l; asm volatile("v_mbcnt_lo_u32_b32 %0, -1, 0\n\tv_mbcnt_hi_u32_b32 %0, -1, %0" : "=v"(l));
    int t; asm volatile("v_lshl_or_b32 %0, %1, 6, %2" : "=v"(t) : "s"(w), "v"(l));
    return t; }

namespace pg8 {
constexpr int BM = 256, BK = 64, HALF = 128, HTB = HALF * BK * 2, STAGE_BYTES = 8 * HTB, NXCD = 8, WGM = 8;
__host__ __device__ __forceinline__ int lds_byte(int r, int c) { const int st = (r >> 4) * 2 + (c >> 5), rr = r & 15, cc = c & 31, ob = rr * 64 + cc * 2; return st * 1024 + (ob ^ (((ob >> 9) & 1) << 5)); }
__host__ __device__ __forceinline__ void stage_rc(int b, int& R, int& C) { const int st = b / 1024, sb = b % 1024, swz = sb ^ (((sb >> 9) & 1) << 5); R = (st >> 1) * 16 + swz / 64; C = (st & 1) * 32 + (swz % 64) / 2; }
__host__ __device__ __forceinline__ int perm32(int rho) { const int n = rho >> 4, i = rho & 15; return 8 * (i >> 2) + 4 * n + (i & 3); }
struct Unit { int pm, pn, ks; };
struct Gemm { const bf16_t* A; const bf16_t* Bt; int M, N, K, lda, ldb; };
struct StaticOrder {
    int nM, nN, nwg, G, c;
    __host__ __device__ void init(int M, int N, int G_, int c_) { nM = M / BM; nN = N / BM; nwg = nM * nN; G = G_; c = c_; }
    __host__ __device__ bool next(int i, Unit& u) const {
        const long L = (long)i * G + c; if (L >= nwg) return false;
        int wgid = (int)L; { const int q = nwg / NXCD, r = nwg % NXCD, xcd = wgid % NXCD, off = wgid / NXCD; wgid = (xcd < r ? xcd * (q + 1) : r * (q + 1) + (xcd - r) * q) + off; }
        const int nig = WGM * nN, gid = wgid / nig, fm = gid * WGM, gsz = (nM - fm) < WGM ? (nM - fm) : WGM;
        u.pm = fm + ((wgid % nig) % gsz); u.pn = (wgid % nig) / gsz; u.ks = 0; return true;
    }
    __device__ __forceinline__ void a_ready(const Unit&) const {}
    __device__ __forceinline__ void done(const Unit&) const {}
};
struct SplitOrder {
    int nM, nN, nS, nwg, G, c;
    __host__ __device__ void init(int M, int N, int nS_, int G_, int c_) { nM = M / BM; nN = N / BM; nS = nS_; nwg = nM * nN * nS; G = G_; c = c_; }
    __host__ __device__ bool next(int i, Unit& u) const { const long L = (long)i * G + c; if (L >= nwg) return false; const int t = (int)L / nS; u.ks = (int)L % nS; u.pm = t % nM; u.pn = t / nM; return true; }
    __device__ __forceinline__ void a_ready(const Unit&) const {}
    __device__ __forceinline__ void done(const Unit&) const {}
};
template <class Epi, class Sched>
__device__ __forceinline__ void gemm_phase(LAS unsigned char* lds, const Gemm g, const Sched& S, const Epi& E) {
    const int tid = ltid(), wid = __builtin_amdgcn_readfirstlane(tid >> 6), lane = tid & 63, wr = wid >> 2, wc = wid & 3, fr = lane & 15, fq = lane >> 4;
    const int K = g.K, nt = K / BK;
    unsigned voffA[2], voffB[2];
#pragma unroll
    for (int i = 0; i < 2; ++i) { int R, C; stage_rc(tid * 16 + i * 8192, R, C); const int Rb = Epi::PERM ? ((R & ~31) + perm32(R & 31)) : R;
        voffA[i] = (unsigned)(R * g.lda + C) * 2u; voffB[i] = (unsigned)(Rb * g.ldb + C) * 2u; }
    const size_t kstep = (size_t)(BK * 2);
    const size_t hstepA = (size_t)HALF * g.lda * 2, hstepB = (size_t)HALF * g.ldb * 2;
    const size_t tstepA = 2 * hstepA, tstepB = 2 * hstepB, sstep = (size_t)K * 2;
    const unsigned ldsw = (unsigned)wid * 1024u;
    const int aoff = lds_byte(wr * 64 + fr, fq * 8), boff = lds_byte(wc * 32 + fr, fq * 8);
#define PG8_SA(b, h) (((b) * 2 + (h)) * HTB)
#define PG8_SB(b, h) ((4 + (b) * 2 + (h)) * HTB)
#define PG8_STAGE(bufoff, gbase, voff) do { _Pragma("unroll") for (int _i = 0; _i < 2; ++_i) \
        __builtin_amdgcn_global_load_lds((const unsigned*)((const char*)(gbase) + (voff)[_i]), (LAS unsigned*)(lds + (bufoff) + ldsw + _i * 8192), 16, 0, 0); } while (0)
#define PG8_LDA(dst, b, h) do { _Pragma("unroll") for (int m = 0; m < 4; ++m) _Pragma("unroll") for (int k = 0; k < 2; ++k) dst[m][k] = *(const LAS bf16x8*)(lds + PG8_SA(b, h) + aoff + m * 2048 + k * 1024); } while (0)
#define PG8_LDB(dst, b, h) do { _Pragma("unroll") for (int n = 0; n < 2; ++n) _Pragma("unroll") for (int k = 0; k < 2; ++k) dst[n][k] = *(const LAS bf16x8*)(lds + PG8_SB(b, h) + boff + n * 2048 + k * 1024); } while (0)
#define PG8_MMA(ai, bj, At, Bt) do { __builtin_amdgcn_s_setprio(1); _Pragma("unroll") for (int m = 0; m < 4; ++m) _Pragma("unroll") for (int n = 0; n < 2; ++n) _Pragma("unroll") for (int k = 0; k < 2; ++k) \
        acc[ai][bj][m][n] = __builtin_amdgcn_mfma_f32_16x16x32_bf16(Bt[n][k], At[m][k], acc[ai][bj][m][n], 0, 0, 0); __builtin_amdgcn_s_setprio(0); } while (0)
#define PG8_WAIT_V(n) asm volatile("s_waitcnt vmcnt(" #n ")" ::: "memory")
#define PG8_WAIT_L(n) asm volatile("s_waitcnt lgkmcnt(" #n ")" ::: "memory")
#define PG8_BAR __builtin_amdgcn_s_barrier()
#define PG8_SCHED __builtin_amdgcn_sched_barrier(0)
    Unit cur, nxt; int ui = 0;
    if (!S.next(0, cur)) return;
    f32x4 acc[2][2][4][2];
#pragma unroll
    for (int a = 0; a < 2; ++a)
#pragma unroll
        for (int b = 0; b < 2; ++b)
#pragma unroll
            for (int m = 0; m < 4; ++m)
#pragma unroll
                for (int n = 0; n < 2; ++n) acc[a][b][m][n] = (f32x4){0.f, 0.f, 0.f, 0.f};
    bf16x8 At[4][2], B0[2][2], B1[2][2];
    const char* cA = (const char*)g.A + (size_t)cur.pm * tstepA + (size_t)cur.ks * sstep; const char* cB = (const char*)g.Bt + (size_t)cur.pn * tstepB + (size_t)cur.ks * sstep;
    S.a_ready(cur);
    PG8_STAGE(PG8_SB(0, 0), cB, voffB); PG8_STAGE(PG8_SA(0, 0), cA, voffA); PG8_STAGE(PG8_SB(0, 1), cB + hstepB, voffB); PG8_STAGE(PG8_SA(0, 1), cA + hstepA, voffA);
    if (wr == 1) PG8_BAR;
    PG8_WAIT_V(4); PG8_BAR;
    PG8_STAGE(PG8_SB(1, 0), cB + kstep, voffB); PG8_STAGE(PG8_SA(1, 0), cA + kstep, voffA); PG8_STAGE(PG8_SB(1, 1), cB + hstepB + kstep, voffB);
    PG8_WAIT_V(6); PG8_BAR;
    for (;;) {
        const bool has_next = S.next(ui + 1, nxt);
        const char* nA = has_next ? (const char*)g.A + (size_t)nxt.pm * tstepA + (size_t)nxt.ks * sstep : cA; const char* nB = has_next ? (const char*)g.Bt + (size_t)nxt.pn * tstepB + (size_t)nxt.ks * sstep : cB;
        for (int t = 0; t < nt; t += 2) {
            const bool last = (t == nt - 2);
            const char* a1 = cA + (size_t)(t + 1) * kstep;
            const char* a2 = last ? nA : cA + (size_t)(t + 2) * kstep; const char* b2 = last ? nB : cB + (size_t)(t + 2) * kstep;
            const char* a3 = a2 + kstep; const char* b3 = b2 + kstep;
            if (last && has_next) S.a_ready(nxt);
            PG8_LDB(B0, 0, 0); PG8_SCHED; PG8_LDA(At, 0, 0); PG8_STAGE(PG8_SA(1, 1), a1 + hstepA, voffA);
            PG8_WAIT_L(8); PG8_BAR; PG8_WAIT_L(0); PG8_MMA(0, 0, At, B0); PG8_BAR; PG8_SCHED;
            PG8_LDB(B1, 0, 1); PG8_STAGE(PG8_SB(0, 0), b2, voffB);
            PG8_BAR; PG8_WAIT_L(0); PG8_MMA(0, 1, At, B1); PG8_BAR;
            PG8_LDA(At, 0, 1); PG8_STAGE(PG8_SA(0, 0), a2, voffA);
            PG8_BAR; PG8_WAIT_L(0); PG8_MMA(1, 0, At, B0); PG8_BAR; PG8_SCHED;
            PG8_STAGE(PG8_SB(0, 1), b2 + hstepB, voffB);
            PG8_WAIT_V(6); PG8_BAR; PG8_MMA(1, 1, At, B1); PG8_BAR;
            PG8_LDB(B0, 1, 0); PG8_SCHED; PG8_LDA(At, 1, 0); PG8_STAGE(PG8_SA(0, 1), a2 + hstepA, voffA);
            PG8_WAIT_L(8); PG8_BAR; PG8_WAIT_L(0); PG8_MMA(0, 0, At, B0); PG8_BAR; PG8_SCHED;
            PG8_LDB(B1, 1, 1); PG8_STAGE(PG8_SB(1, 0), b3, voffB);
            PG8_BAR; PG8_WAIT_L(0); PG8_MMA(0, 1, At, B1); PG8_BAR;
            PG8_LDA(At, 1, 1); PG8_STAGE(PG8_SA(1, 0), a3, voffA);
            PG8_BAR; PG8_WAIT_L(0); PG8_MMA(1, 0, At, B0); PG8_BAR; PG8_SCHED;
            PG8_STAGE(PG8_SB(1, 1), b3 + hstepB, voffB);
            PG8_WAIT_V(6); PG8_BAR; PG8_MMA(1, 1, At, B1); PG8_BAR;
        }
        E(acc, cur, wr, wc, fr, fq); S.done(cur);
        if (!has_next) break;
#pragma unroll
        for (int a = 0; a < 2; ++a)
#pragma unroll
            for (int b = 0; b < 2; ++b)
#pragma unroll
                for (int m = 0; m < 4; ++m)
#pragma unroll
                    for (int n = 0; n < 2; ++n) acc[a][b][m][n] = (f32x4){0.f, 0.f, 0.f, 0.f};
        cur = nxt; cA = nA; cB = nB; ++ui;
    }
    PG8_WAIT_V(0);
    if (wr == 0) PG8_BAR;
    PG8_BAR;
#undef PG8_SA
#undef PG8_SB
#undef PG8_STAGE
#undef PG8_LDA
#undef PG8_LDB
#undef PG8_MMA
#undef PG8_WAIT_V
#undef PG8_WAIT_L
#undef PG8_BAR
#undef PG8_SCHED
}
}

template <class F> struct Epi4 {
    static constexpr bool PERM = false, AFTER_DRAIN = false; F f;
    __device__ __forceinline__ void operator()(const f32x4 (&acc)[2][2][4][2], const pg8::Unit& u, int wr, int wc, int fr, int fq) const {
#pragma unroll
        for (int ai = 0; ai < 2; ++ai)
#pragma unroll
            for (int m = 0; m < 4; ++m) { const int row = u.pm * 256 + ai * 128 + wr * 64 + m * 16 + fr;
#pragma unroll
                for (int bj = 0; bj < 2; ++bj)
#pragma unroll
                    for (int n = 0; n < 2; ++n) f(row, u.pn * 256 + bj * 128 + wc * 32 + n * 16 + 4 * fq, acc[ai][bj][m][n]); }
    }
};
template <class F> struct Epi8 {
    static constexpr bool PERM = true, AFTER_DRAIN = false; F f;
    __device__ __forceinline__ void operator()(const f32x4 (&acc)[2][2][4][2], const pg8::Unit& u, int wr, int wc, int fr, int fq) const {
#pragma unroll
        for (int ai = 0; ai < 2; ++ai)
#pragma unroll
            for (int m = 0; m < 4; ++m) { const int row = u.pm * 256 + ai * 128 + wr * 64 + m * 16 + fr;
#pragma unroll
                for (int bj = 0; bj < 2; ++bj) f(row, u.pn * 256 + bj * 128 + wc * 32 + 8 * fq, acc[ai][bj][m][0], acc[ai][bj][m][1]); }
    }
};
struct EpiSlab {
    static constexpr bool PERM = false, AFTER_DRAIN = false; float* C; int ldc; size_t slab;
    __device__ __forceinline__ void operator()(const f32x4 (&acc)[2][2][4][2], const pg8::Unit& u, int wr, int wc, int fr, int fq) const {
        float* base = C + (size_t)u.ks * slab;
#pragma unroll
        for (int ai = 0; ai < 2; ++ai)
#pragma unroll
            for (int m = 0; m < 4; ++m) { const int row = u.pm * 256 + ai * 128 + wr * 64 + m * 16 + fr;
#pragma unroll
                for (int bj = 0; bj < 2; ++bj)
#pragma unroll
                    for (int n = 0; n < 2; ++n) *(f32x4*)(base + (size_t)row * ldc + u.pn * 256 + bj * 128 + wc * 32 + n * 16 + 4 * fq) = acc[ai][bj][m][n]; }
    }
};
__device__ __forceinline__ int modrow(int row) { return row < NLAT ? (row >> 12) : 2; }
struct FRes { float* xs; const float* g;
    __device__ __forceinline__ void operator()(int row, int col, f32x4 v) const {
        float* p = xs + (size_t)row * DM + col; const f32x4 gg = *(const f32x4*)(g + modrow(row) * 6 * DM + col);
        f32x4 x = *(const f32x4*)p; x += gg * v; *(f32x4*)p = x; } };
struct FGlu { float* xs; const float* xr; const float* g; const bf16_t* z; const float* bglu;
    __device__ __forceinline__ void operator()(int row, int col, f32x4 v) const {
        float* p = xs + (size_t)row * DM + col; const float* pr = xr + (size_t)row * DM + col; const f32x4 gg = *(const f32x4*)(g + modrow(row) * 6 * DM + col); const f32x4 bb = *(const f32x4*)(bglu + col);
        const u32x2 zz = *(const u32x2*)(z + (size_t)row * DM + col);
        const float z0 = __uint_as_float(zz.x << 16), z1 = __uint_as_float(zz.x & 0xffff0000u), z2 = __uint_as_float(zz.y << 16), z3 = __uint_as_float(zz.y & 0xffff0000u);
        f32x4 x = *(const f32x4*)pr;
        x[0] += gg[0] * z0 * sigmoidf_(v[0] + bb[0]); x[1] += gg[1] * z1 * sigmoidf_(v[1] + bb[1]);
        x[2] += gg[2] * z2 * sigmoidf_(v[2] + bb[2]); x[3] += gg[3] * z3 * sigmoidf_(v[3] + bb[3]);
        *(f32x4*)p = x; } };
struct FUp { bf16_t* h;
    __device__ __forceinline__ void operator()(int row, int col, f32x4 a, f32x4 b) const {
        f32x4 r0 = __builtin_elementwise_max(a, (f32x4){0.f, 0.f, 0.f, 0.f}), r1 = __builtin_elementwise_max(b, (f32x4){0.f, 0.f, 0.f, 0.f}); r0 *= r0; r1 *= r1;
        u32x4 w; w.x = pk2(r0[0], r0[1]); w.y = pk2(r0[2], r0[3]); w.z = pk2(r1[0], r1[1]); w.w = pk2(r1[2], r1[3]);
        *(u32x4*)(h + (size_t)row * DFF + col) = w; } };
struct FF32 { float* C; int ldc;
    __device__ __forceinline__ void operator()(int row, int col, f32x4 v) const { *(f32x4*)(C + (size_t)row * ldc + col) = v; } };
__device__ __forceinline__ void row_bk(int row, int& b, int& key, int& lpos) {
    if (row < NLAT) { b = row >> 12; lpos = row & (SEQ - 1); key = CTX + lpos; } else { const int r = row - NLAT; b = r >> 8; key = r & (CTX - 1); lpos = -1; } }
struct FUq { bf16_t* Q; const float* rope; float qscale;
    __device__ __forceinline__ void operator()(int row, int col, f32x4 a, f32x4 b) const {
        int bb, key, lpos; row_bk(row, bb, key, lpos);
        const int h = col / DQK, e = col - h * DQK;
        if (e >= DN && lpos >= 0) { const int ep = e - DN, axis = ep >> 5, f0 = (ep & 31) >> 1;
            const f32x4 cs0 = *(const f32x4*)(rope + ((size_t)(lpos * 2 + axis) * 16 + f0) * 2), cs1 = *(const f32x4*)(rope + ((size_t)(lpos * 2 + axis) * 16 + f0 + 2) * 2);
            f32x4 na, nb;
            na[0] = a[0] * cs0[0] - a[1] * cs0[1]; na[1] = a[0] * cs0[1] + a[1] * cs0[0]; na[2] = a[2] * cs0[2] - a[3] * cs0[3]; na[3] = a[2] * cs0[3] + a[3] * cs0[2];
            nb[0] = b[0] * cs1[0] - b[1] * cs1[1]; nb[1] = b[0] * cs1[1] + b[1] * cs1[0]; nb[2] = b[2] * cs1[2] - b[3] * cs1[3]; nb[3] = b[2] * cs1[3] + b[3] * cs1[2];
            a = na; b = nb; }
        a *= qscale; b *= qscale;
        u32x4 w; w.x = pk2(a[0], a[1]); w.y = pk2(a[2], a[3]); w.z = pk2(b[0], b[1]); w.w = pk2(b[2], b[3]);
        *(u32x4*)(Q + ((size_t)(bb * NH + h) * NKEY + key) * DQK + e) = w; } };
struct FUkv { bf16_t* Kb; bf16_t* Vb;
    __device__ __forceinline__ void operator()(int row, int col, f32x4 a, f32x4 b) const {
        int bb, key, lpos; row_bk(row, bb, key, lpos);
        const int h = col >> 8, e = col & 255;
        u32x4 w; w.x = pk2(a[0], a[1]); w.y = pk2(a[2], a[3]); w.z = pk2(b[0], b[1]); w.w = pk2(b[2], b[3]);
        bf16_t* dst = (e < DN ? Kb : Vb) + ((size_t)(bb * NH + h) * NKEY + key) * DN + (e & 127);
        *(u32x4*)dst = w; } };

struct P {
    const float *x, *c, *ctx, *cctx, *ada_w, *ada_b, *norm1_g, *norm2_g, *final_g, *lam_re, *lam_im, *log_dt, *b_re, *b_im, *c_re, *c_im, *s5_d, *w_glu, *b_glu;
    const float *w_dq, *q_norm, *w_uq, *w_dkv, *kv_norm, *w_ukv, *w_o, *ffn_w1, *ffn_w2;
    float* out; char* ws;
};
constexpr int LDS_BYTES = 163840;
constexpr int LDS_CTL = LDS_BYTES - 16;
typedef const __attribute__((address_space(4))) P* KP;
__device__ __forceinline__ KP kp() { KP k = (KP)__builtin_amdgcn_kernarg_segment_ptr(); asm volatile("" : "+s"(k)); return k; }

#define XB_TMO      128
#define XB_XCNT(j)  (256  + 64 * (j))
#define XB_XSUB(j)  (1280 + 64 * (j))
#define XB_XGEN(j)  (2304 + 64 * (j))
#define XB_TOP      3328
#define XB_TOPGEN   3392
#define XCD_BAR_WORDS 3456
#define XB_SPIN_CAP (1u << 18)
__device__ __forceinline__ unsigned xb_ld(unsigned* p)              { return __hip_atomic_load(p, __ATOMIC_RELAXED, __HIP_MEMORY_SCOPE_AGENT); }
__device__ __forceinline__ unsigned xb_add(unsigned* p, unsigned v) { return __hip_atomic_fetch_add(p, v, __ATOMIC_RELAXED, __HIP_MEMORY_SCOPE_AGENT); }
__device__ __forceinline__ unsigned xb_xcc_id() { return (unsigned)__builtin_amdgcn_s_getreg((3 << 11) | 20) & 0xFu; }
#define XB_SPIN(cond, bar) do { unsigned _sp = 0; while (cond) { __builtin_amdgcn_s_sleep(1); \
    if ((++_sp & 255u) == 0u) { if (xb_ld(&(bar)[XB_TMO])) break; if (_sp > XB_SPIN_CAP) { atomicAdd(&(bar)[XB_TMO], 1u); break; } } } } while (0)
struct XcdBarrier { unsigned* bar; unsigned x; volatile LAS unsigned* st; };
__device__ __forceinline__ XcdBarrier xcd_barrier_post(unsigned* bar, volatile LAS unsigned* st) {
    XcdBarrier b; b.bar = bar; b.x = xb_xcc_id(); b.st = st;
    if (threadIdx.x == 0) (void)xb_add(&bar[XB_XCNT(b.x)], 1u);
    return b;
}
__device__ __forceinline__ void xcd_barrier_complete(unsigned* bar, unsigned x, unsigned& nloc, unsigned& nx) {
    const unsigned G = gridDim.x * gridDim.y * gridDim.z;
    unsigned sum, cnt, mine, sp = 0u;
    for (;;) {
        sum = 0u; cnt = 0u; mine = 0u;
#pragma unroll
        for (unsigned j = 0; j < 16; ++j) { const unsigned c = xb_ld(&bar[XB_XCNT(j)]); sum += c; cnt += (c > 0u) ? 1u : 0u; mine = (j == x) ? c : mine; }
        if (sum == G) break;
        __builtin_amdgcn_s_sleep(1);
        if ((++sp & 255u) == 0u) { if (xb_ld(&bar[XB_TMO])) break; if (sp > XB_SPIN_CAP) { atomicAdd(&bar[XB_TMO], 1u); break; } }
    }
    nloc = mine > 0u ? mine : 1u; nx = cnt > 0u ? cnt : 1u;
}
__device__ __forceinline__ void xcd_barrier(const XcdBarrier& b) {
    asm volatile("s_waitcnt vmcnt(0)" ::: "memory");
    __syncthreads();
    if (threadIdx.x == 0) {
        unsigned* bar = (unsigned*)(kp()->ws + OFF_BAR);
        __builtin_amdgcn_s_waitcnt(0);
        unsigned nloc = b.st[0], nx = b.st[1];
        unsigned bx = b.x; asm volatile("" : "+s"(bx));
        if (nloc == 0u) { xcd_barrier_complete(bar, bx, nloc, nx); b.st[0] = nloc; b.st[1] = nx; }
        const unsigned old = xb_add(&bar[XB_XSUB(bx)], 1u);
        const unsigned gen = old / nloc;
        if (old + 1u == (gen + 1u) * nloc) {
            __builtin_amdgcn_fence(__ATOMIC_RELEASE, "agent");
            asm volatile("s_waitcnt vmcnt(0)" ::: "memory");
            const unsigned og = xb_add(&bar[XB_TOP], 1u);
            const unsigned tg = og / nx;
            if (og + 1u == (tg + 1u) * nx) xb_add(&bar[XB_TOPGEN], 1u);
            else XB_SPIN(xb_ld(&bar[XB_TOPGEN]) == tg, bar);
            __builtin_amdgcn_fence(__ATOMIC_ACQUIRE, "agent");
            xb_add(&bar[XB_XGEN(bx)], 1u);
            asm volatile("s_waitcnt vmcnt(0)" ::: "memory");
        } else {
            XB_SPIN(xb_ld(&bar[XB_XGEN(bx)]) == gen, bar);
            __builtin_amdgcn_fence(__ATOMIC_ACQUIRE, "agent");
            asm volatile("s_waitcnt vmcnt(0)" ::: "memory");
        }
    }
    __syncthreads();
}

namespace s5f {
constexpr int NTILE = 34;
constexpr int TB_PT = 0, TB_QT = 32768, TB_KT = 65536, TB_LP = 73728, TB_STRIDE = 77824;
constexpr int L_PT = 0, L_QT = 32768, L_KT = 65536, L_HB = 73728, HB_ROW = 272, HB_WAVE = 16 * HB_ROW, L_ET = L_HB + 8 * HB_WAVE, L_END = L_ET + NTILE * 128 * 4;
typedef float f32x2v __attribute__((ext_vector_type(2)));
__device__ __forceinline__ f32x2v cmul(f32x2v a, f32x2v b) { return (f32x2v){a.x * b.x - a.y * b.y, a.x * b.y + a.y * b.x}; }

__device__ __forceinline__ void make_tables(int jdg, const P& p, char* tb, char* lds) {
    const int tid = ltid();
    f32x2v* lp = (f32x2v*)lds;
    f32x2v* bb = lp + 9 * 64;
    f32x2v* cc = bb + 64 * 16;
    float* kd = (float*)(cc + 16 * 64);
    __syncthreads();
    if (tid < 64) { const int i = jdg * 64 + tid;
        const double dt = exp((double)p.log_dt[jdg]); const double lr = p.lam_re[i], li = p.lam_im[i];
        float* lpo = (float*)(tb + TB_LP);
#pragma unroll 1
        for (int k = 0; k <= 12; ++k) { const int e = k <= 8 ? k : (k - 8) * 32;
            const double mag = exp(lr * dt * e); double sn, cs; sincos_d(li * dt * e, sn, cs);
            const f32x2v v = {(float)(mag * cs), (float)(mag * sn)};
            if (k <= 8) lp[k * 64 + tid] = v;
            if (k >= 8) { lpo[((k - 8) * 64 + tid) * 2] = v.x; lpo[((k - 8) * 64 + tid) * 2 + 1] = v.y; } }
        const double mag = exp(lr * dt); double sn, cs; sincos_d(li * dt, sn, cs);
        const double lbr = mag * cs, lbi = mag * sn, nr = lbr - 1.0, den = lr * lr + li * li;
        const double fr = (nr * lr + lbi * li) / den, fi = (lbi * lr - nr * li) / den;
#pragma unroll 1
        for (int c = 0; c < GC; ++c) { const double br = p.b_re[(size_t)i * GC + c], bi = p.b_im[(size_t)i * GC + c];
            bb[tid * 16 + c] = (f32x2v){(float)(fr * br - fi * bi), (float)(fr * bi + fi * br)}; } }
    for (int i = tid; i < 1024; i += 512) cc[i] = (f32x2v){p.c_re[(size_t)jdg * 1024 + i], p.c_im[(size_t)jdg * 1024 + i]};
    __syncthreads();
    for (int o = tid; o < 2048; o += 512) { const int d = o >> 8, co = (o >> 4) & 15, ci = o & 15; float s = 0.f;
        for (int q = 0; q < 64; ++q) { const f32x2v w = cmul(cc[co * 64 + q], lp[d * 64 + q]); const f32x2v b = bb[q * 16 + ci]; s += w.x * b.x - w.y * b.y; }
        if (d == 0 && co == ci && ((jdg >> 7) & 1) == 0) s += p.s5_d[(size_t)(jdg >> 8) * DM + (jdg & 127) * 16 + co];
        kd[o] = s; }
    for (int f = tid; f < 2048; f += 512) { const int nt = f >> 8, kk = (f >> 6) & 3, l = f & 63;
        const int s = 2 * kk + (l >> 5), n = 16 * nt + (l & 15), pp = n & 63; const f32x2v w = lp[(7 - s) * 64 + pp]; float v[8];
#pragma unroll
        for (int e = 0; e < 8; ++e) { const f32x2v pr = cmul(w, bb[pp * 16 + 8 * ((l >> 4) & 1) + e]); v[e] = n < 64 ? pr.x : pr.y; }
        u32x4 o; o.x = pk2(v[0], v[1]); o.y = pk2(v[2], v[3]); o.z = pk2(v[4], v[5]); o.w = pk2(v[6], v[7]); *(u32x4*)(tb + TB_PT + f * 16) = o; }
    for (int f = tid; f < 2048; f += 512) { const int t = f >> 8, kk = (f >> 6) & 3, l = f & 63; const int co = l & 15; float v[8];
#pragma unroll
        for (int e = 0; e < 8; ++e) { const int n = 32 * kk + 8 * (l >> 4) + e, pp = n & 63; const f32x2v d = cmul(cc[co * 64 + pp], lp[(t + 1) * 64 + pp]); v[e] = n < 64 ? d.x : -d.y; }
        u32x4 o; o.x = pk2(v[0], v[1]); o.y = pk2(v[2], v[3]); o.z = pk2(v[4], v[5]); o.w = pk2(v[6], v[7]); *(u32x4*)(tb + TB_QT + f * 16) = o; }
    __syncthreads();
    { const int D = tid >> 6, l = tid & 63, dl = D - (l >> 5), co = l & 15, c0 = 8 * ((l >> 4) & 1); float v[8];
#pragma unroll
      for (int e = 0; e < 8; ++e) v[e] = dl >= 0 ? kd[(dl * 16 + co) * 16 + c0 + e] : 0.f;
      u32x4 o; o.x = pk2(v[0], v[1]); o.y = pk2(v[2], v[3]); o.z = pk2(v[4], v[5]); o.w = pk2(v[6], v[7]); *(u32x4*)(tb + TB_KT + tid * 16) = o; }
}

__device__ __forceinline__ void unit(int g, int b, int j, const bf16_t* __restrict__ abuf, const char* __restrict__ tabs, const float* __restrict__ dsk, float* __restrict__ yf, bf16_t* __restrict__ zbuf, char* lds) {
    const int tid = ltid(), wid = __builtin_amdgcn_readfirstlane(tid >> 6), lane = tid & 63, jj = lane & 15, q = lane >> 4;
    char* hb = lds + L_HB + wid * HB_WAVE; float* et = (float*)(lds + L_ET);
#pragma unroll 1
    for (int dir = 0; dir < 2; ++dir) {
        const char* tb = tabs + (size_t)((j * 2 + dir) * NG + g) * TB_STRIDE;
        __syncthreads();
#pragma unroll
        for (int i = 0; i < 9; ++i) { const int o = (tid + i * 512) * 16; if (o < L_HB) *(u32x4*)(lds + o) = *(const u32x4*)(tb + o); }
        f32x2v a[4], wA[4], wX[4], w1[4], w2[4], w3[4];
        { const f32x2v* lp = (const f32x2v*)(tb + TB_LP);
#pragma unroll
          for (int st = 0; st < 4; ++st) { const int pp = 16 * st + jj; const f32x2v one = {1.f, 0.f}, zero = {0.f, 0.f};
              const f32x2v a1 = lp[pp], a4 = lp[64 + pp], a8 = lp[128 + pp], a12 = lp[192 + pp];
              a[st] = a1;
              wA[st] = q == 3 ? one : q == 2 ? a4 : q == 1 ? a8 : a12;
              wX[st] = q == 0 ? one : q == 1 ? a4 : q == 2 ? a8 : a12;
              { const int qq = q ^ 1, m = q - 1 - qq; w1[st] = qq < q ? (m == 0 ? one : m == 1 ? a4 : a8) : zero; }
              { const int qq = q ^ 2, m = q - 1 - qq; w2[st] = qq < q ? (m == 0 ? one : m == 1 ? a4 : a8) : zero; }
              { const int qq = q ^ 3, m = q - 1 - qq; w3[st] = qq < q ? (m == 0 ? one : m == 1 ? a4 : a8) : zero; } } }
        __syncthreads();
        const int sgn = dir ? -1 : 1;
#define S5_RBASE(T) ((T) < 2 ? (dir ? NLAT + b * CTX + 255 - 128 * (T) : NLAT + b * CTX + 128 * (T)) : (dir ? b * SEQ + 4095 - 128 * ((T) - 2) : b * SEQ + 128 * ((T) - 2)))
#define S5_LDU(dst, T) do { const int rb_ = S5_RBASE(T); _Pragma("unroll") for (int kk = 0; kk < 4; ++kk) { const int row = rb_ + sgn * (8 * jj + 2 * kk + (lane >> 5)); dst[kk] = *(const bf16x8*)(abuf + (unsigned)(row * DM + g * 16 + 8 * (q & 1))); } } while (0)
        { bf16x8 au[4], aun[4]; S5_LDU(au, wid);
        for (int T_ = wid; T_ < NTILE; T_ += 8) {
            if (T_ + 8 < NTILE) S5_LDU(aun, T_ + 8);
            f32x4 sacc[8];
#pragma unroll
            for (int nt = 0; nt < 8; ++nt) { sacc[nt] = (f32x4){0.f, 0.f, 0.f, 0.f};
#pragma unroll
                for (int kk = 0; kk < 4; ++kk) sacc[nt] = __builtin_amdgcn_mfma_f32_16x16x32_bf16(au[kk], *(const bf16x8*)(lds + L_PT + ((nt * 4 + kk) * 64 + lane) * 16), sacc[nt], 0, 0, 0); }
#pragma unroll
            for (int st = 0; st < 4; ++st) { f32x2v L = {sacc[st][0], sacc[st + 4][0]};
#pragma unroll
                for (int i = 1; i < 4; ++i) { L = cmul(a[st], L); L.x += sacc[st][i]; L.y += sacc[st + 4][i]; }
                f32x2v G = cmul(wA[st], L);
                G.x += __shfl_xor(G.x, 16); G.y += __shfl_xor(G.y, 16); G.x += __shfl_xor(G.x, 32); G.y += __shfl_xor(G.y, 32);
                if (q == 0) { et[T_ * 128 + 16 * st + jj] = G.x; et[T_ * 128 + 64 + 16 * st + jj] = G.y; } }
#pragma unroll
            for (int kk = 0; kk < 4; ++kk) au[kk] = aun[kk];
        } }
        __syncthreads();
        if (wid == 0) { const f32x2v a128 = ((const f32x2v*)(tb + TB_LP))[256 + lane]; f32x2v X = {0.f, 0.f};
#pragma unroll 1
            for (int T_ = 0; T_ < NTILE; ++T_) { const f32x2v e = {et[T_ * 128 + lane], et[T_ * 128 + 64 + lane]}; et[T_ * 128 + lane] = X.x; et[T_ * 128 + 64 + lane] = X.y; X = cmul(a128, X); X.x += e.x; X.y += e.y; } }
        __syncthreads();
        { bf16x8 au[4]; S5_LDU(au, wid);
        for (int T_ = wid; T_ < NTILE; T_ += 8) {
            const int rbase = S5_RBASE(T_);
            f32x4 sacc[8];
#pragma unroll
            for (int nt = 0; nt < 8; ++nt) { sacc[nt] = (f32x4){0.f, 0.f, 0.f, 0.f};
#pragma unroll
                for (int kk = 0; kk < 4; ++kk) sacc[nt] = __builtin_amdgcn_mfma_f32_16x16x32_bf16(au[kk], *(const bf16x8*)(lds + L_PT + ((nt * 4 + kk) * 64 + lane) * 16), sacc[nt], 0, 0, 0); }
#pragma unroll
            for (int st = 0; st < 4; ++st) {
                f32x2v L = {sacc[st][0], sacc[st + 4][0]};
#pragma unroll
                for (int i = 1; i < 4; ++i) { L = cmul(a[st], L); L.x += sacc[st][i]; L.y += sacc[st + 4][i]; }
                const f32x2v G1 = {__shfl_xor(L.x, 16), __shfl_xor(L.y, 16)}, G2 = {__shfl_xor(L.x, 32), __shfl_xor(L.y, 32)}, G3 = {__shfl_xor(L.x, 48), __shfl_xor(L.y, 48)};
                const f32x2v X = {et[T_ * 128 + 16 * st + jj], et[T_ * 128 + 64 + 16 * st + jj]};
                f32x2v H = cmul(wX[st], X); { const f32x2v t1 = cmul(w1[st], G1), t2 = cmul(w2[st], G2), t3 = cmul(w3[st], G3); H.x += t1.x + t2.x + t3.x; H.y += t1.y + t2.y + t3.y; }
#pragma unroll
                for (int i = 0; i < 4; ++i) {
                    *(bf16_t*)(hb + (4 * q + i) * HB_ROW + (16 * st + jj) * 2) = f2bf(H.x); *(bf16_t*)(hb + (4 * q + i) * HB_ROW + (64 + 16 * st + jj) * 2) = f2bf(H.y);
                    H = cmul(a[st], H); H.x += sacc[st][i]; H.y += sacc[st + 4][i]; } }
            asm volatile("s_waitcnt lgkmcnt(0)" ::: "memory");
            f32x4 yfv[8];
            if (dir) {
#pragma unroll
                for (int i = 0; i < 4; ++i)
#pragma unroll
                    for (int t = 0; t < 8; ++t) yfv[t][i] = yf[(unsigned)((rbase + sgn * (8 * (4 * q + i) + t)) * DM + g * 16 + jj)]; }
            bf16x8 ah[4];
#pragma unroll
            for (int kk = 0; kk < 4; ++kk) ah[kk] = *(const bf16x8*)(hb + jj * HB_ROW + (32 * kk + 8 * q) * 2);
            f32x4 yacc[8];
#pragma unroll
            for (int t = 0; t < 8; ++t) { yacc[t] = (f32x4){0.f, 0.f, 0.f, 0.f};
#pragma unroll
                for (int kk = 0; kk < 4; ++kk) { if (t - 2 * kk >= 0) yacc[t] = __builtin_amdgcn_mfma_f32_16x16x32_bf16(au[kk], *(const bf16x8*)(lds + L_KT + ((t - 2 * kk) * 64 + lane) * 16), yacc[t], 0, 0, 0); }
#pragma unroll
                for (int kk = 0; kk < 4; ++kk) yacc[t] = __builtin_amdgcn_mfma_f32_16x16x32_bf16(ah[kk], *(const bf16x8*)(lds + L_QT + ((t * 4 + kk) * 64 + lane) * 16), yacc[t], 0, 0, 0); }
            if (T_ + 8 < NTILE) S5_LDU(au, T_ + 8);
#pragma unroll
            for (int i = 0; i < 4; ++i)
#pragma unroll
                for (int t = 0; t < 8; ++t) { const int row = rbase + sgn * (8 * (4 * q + i) + t); const unsigned o = (unsigned)(row * DM + g * 16 + jj);
                    if (dir == 0) yf[o] = yacc[t][i];
                    else zbuf[o] = f2bf(gelu_tanh(yacc[t][i] + yfv[t][i])); }
        } }
#undef S5_RBASE
#undef S5_LDU
    }
}
}

struct CvtTile { const float* src; bf16_t* dst; int ld, K, k0, n0; };
__device__ __forceinline__ void cvt_tile_fast2(const CvtTile& ta, const CvtTile& tb, const bool has_b, float* tile  ) {
    const int tid = ltid();
    f32x4 va[8], vb[8];
#pragma unroll
    for (int i = 0; i < 8; ++i) { const int idx = tid + i * 512, k = idx >> 6, c4 = idx & 63; va[i] = *(const f32x4*)(ta.src + (size_t)(ta.k0 + k) * ta.ld + ta.n0 + 4 * c4); }
    if (has_b) {
#pragma unroll
        for (int i = 0; i < 8; ++i) { const int idx = tid + i * 512, k = idx >> 6, c4 = idx & 63; vb[i] = *(const f32x4*)(tb.src + (size_t)(tb.k0 + k) * tb.ld + tb.n0 + 4 * c4); } }
#pragma unroll
    for (int i = 0; i < 8; ++i) { const int idx = tid + i * 512, k = idx >> 6, c4 = idx & 63; float* t = tile + k * 257 + 4 * c4; t[0] = va[i][0]; t[1] = va[i][1]; t[2] = va[i][2]; t[3] = va[i][3]; }
    if (has_b) {
#pragma unroll
        for (int i = 0; i < 8; ++i) { const int idx = tid + i * 512, k = idx >> 6, c4 = idx & 63; float* t = tile + 64 * 257 + k * 257 + 4 * c4; t[0] = vb[i][0]; t[1] = vb[i][1]; t[2] = vb[i][2]; t[3] = vb[i][3]; } }
    __syncthreads();
#pragma unroll
    for (int i = 0; i < 4; ++i) { const int id = tid + i * 512, n = id >> 3, kc = (id & 7) * 8; const float* t = tile + kc * 257 + n;
        u32x4 w; w.x = pk2(t[0], t[257]); w.y = pk2(t[2 * 257], t[3 * 257]); w.z = pk2(t[4 * 257], t[5 * 257]); w.w = pk2(t[6 * 257], t[7 * 257]);
        *(u32x4*)(ta.dst + (size_t)(ta.n0 + n) * ta.K + ta.k0 + kc) = w; }
    if (has_b) {
#pragma unroll
        for (int i = 0; i < 4; ++i) { const int id = tid + i * 512, n = id >> 3, kc = (id & 7) * 8; const float* t = tile + 64 * 257 + kc * 257 + n;
            u32x4 w; w.x = pk2(t[0], t[257]); w.y = pk2(t[2 * 257], t[3 * 257]); w.z = pk2(t[4 * 257], t[5 * 257]); w.w = pk2(t[6 * 257], t[7 * 257]);
            *(u32x4*)(tb.dst + (size_t)(tb.n0 + n) * tb.K + tb.k0 + kc) = w; } }
    __syncthreads();
}
__device__ __forceinline__ void cvt_tile_map(const float* src0, int ld0, const float* src1, int ld1, int K, int mode, bf16_t* dst, int k0, int n0, float* tile  ) {
    const int tid = ltid();
    { const int n = n0 + (tid & 63); const float* sp = nullptr; int ld = 0;
      if (mode == 1) { if (n < 512) { sp = src0 + n; ld = ld0; } else if (n < 1024) { sp = src1 + (n - 512); ld = ld1; } else if (n < 1088) { sp = src1 + 512 + rope_srcd(n - 1024); ld = ld1; } }
      else { const int h = n / DQK, e = n - h * DQK; sp = src0 + (e < DN ? n : h * DQK + DN + rope_srcd(e - DN)); ld = ld0; }
#pragma unroll
      for (int i = 0; i < 8; ++i) { const int k = i * 8 + (tid >> 6); tile[k * 65 + (tid & 63)] = sp ? sp[(size_t)(k0 + k) * ld] : 0.f; } }
    __syncthreads();
    { const int n = tid >> 3, kc = (tid & 7) * 8; const float* t = tile + kc * 65 + n;
      u32x4 w; w.x = pk2(t[0], t[65]); w.y = pk2(t[2 * 65], t[3 * 65]); w.z = pk2(t[4 * 65], t[5 * 65]); w.w = pk2(t[6 * 65], t[7 * 65]);
      *(u32x4*)(dst + (size_t)(n0 + n) * K + k0 + kc) = w; }
    __syncthreads();
}
__device__ __forceinline__ void ada_unit(int u, const float* ada_w, const float* ada_b, float* mod, const float* sl  , float* red  ) {
    const int tid = ltid(), w = tid >> 6, l = tid & 63, cq = l & 15, ko = l >> 4;
    const int layer = u / 192, col0 = (u % 192) * 64;
    float acc[3][4];
#pragma unroll
    for (int r = 0; r < 3; ++r)
#pragma unroll
        for (int j = 0; j < 4; ++j) acc[r][j] = 0.f;
    const float* wp = ada_w + ((size_t)layer * DM + 256 * w + ko) * (6 * DM) + col0 + 4 * cq;
#pragma unroll 8
    for (int it = 0; it < 64; ++it) { const int k = 256 * w + 4 * it + ko;
        const f32x4 wv = *(const f32x4*)(wp + (size_t)it * 4 * (6 * DM)); const f32x4 sv = *(const f32x4*)(sl + k * 4);
#pragma unroll
        for (int r = 0; r < 3; ++r)
#pragma unroll
            for (int j = 0; j < 4; ++j) acc[r][j] += sv[r] * wv[j]; }
#pragma unroll
    for (int r = 0; r < 3; ++r)
#pragma unroll
        for (int j = 0; j < 4; ++j) { float v = acc[r][j]; v += __shfl_xor(v, 16); v += __shfl_xor(v, 32); acc[r][j] = v; }
    if (ko == 0) {
#pragma unroll
        for (int r = 0; r < 3; ++r)
#pragma unroll
            for (int j = 0; j < 4; ++j) red[(w * 16 + cq) * 12 + r * 4 + j] = acc[r][j]; }
    __syncthreads();
    if (tid < 192) { const int q = tid / 12, j = tid % 12, r = j >> 2, cc = j & 3; float s = 0.f;
#pragma unroll
        for (int ww = 0; ww < 8; ++ww) s += red[(ww * 16 + q) * 12 + j];
        const int n = col0 + 4 * q + cc; s += ada_b[(size_t)layer * 6 * DM + n];
        mod[((size_t)(layer * 3 + r) * 6 + (n >> 11)) * DM + (n & (DM - 1))] = s; }
    __syncthreads();
}
__device__ __forceinline__ void misc_phase(const P& p, int gid, int nth) {
    float* rope = (float*)(p.ws + OFF_ROPE);
    for (int i = gid; i < SEQ * 32; i += nth) { const int l = i >> 5, axis = (i >> 4) & 1, f = i & 15;
        const float inv = (float)exp2(-(double)f / 16.0 * 13.287712379549449);
        const float pos = (float)(axis == 0 ? (l >> 6) : (l & 63)); const float ang = pos * inv;
        double s, c; sincos_d((double)ang, s, c); rope[(size_t)i * 2] = (float)c; rope[(size_t)i * 2 + 1] = (float)s; }
}
__device__ __forceinline__ void convert_layer(const int L, const P& p, const int rank, const int nranks, unsigned char* lds) {
    float* tile = (float*)lds; const int j = L >> 1; const bool mla = (L & 1) != 0;
    bf16_t* w1t = (bf16_t*)(p.ws + OFF_W1T); bf16_t* w2t = (bf16_t*)(p.ws + OFF_W2T); bf16_t* wglut = (bf16_t*)(p.ws + OFF_WGLUT); bf16_t* wot = (bf16_t*)(p.ws + OFF_WOT);
    bf16_t* wdqkvt = (bf16_t*)(p.ws + OFF_WDQKVT); bf16_t* wuqt = (bf16_t*)(p.ws + OFF_WUQT); bf16_t* wukvt = (bf16_t*)(p.ws + OFF_WUKVT);
    const int nfast = 2048 + (mla ? 384 : 256);
    auto decode = [&](int t, CvtTile& c) {
        int kt, nt_;
        if (t < 1024) { c.src = p.ffn_w1 + (size_t)L * DM * DFF; c.dst = w1t + (size_t)L * DFF * DM; c.ld = DFF; c.K = DM; kt = t & 31; nt_ = t >> 5; }
        else if (t < 2048) { const int r = t - 1024; c.src = p.ffn_w2 + (size_t)L * DFF * DM; c.dst = w2t + (size_t)L * DM * DFF; c.ld = DM; c.K = DFF; kt = r & 127; nt_ = r >> 7; }
        else if (!mla) { const int r = t - 2048; c.src = p.w_glu + (size_t)j * DM * DM; c.dst = wglut + (size_t)j * DM * DM; c.ld = DM; c.K = DM; kt = r & 31; nt_ = r >> 5; }
        else if (t < 2304) { const int r = t - 2048; c.src = p.w_o + (size_t)j * DM * DM; c.dst = wot + (size_t)j * DM * DM; c.ld = DM; c.K = DM; kt = r & 31; nt_ = r >> 5; }
        else { const int r = t - 2304; c.src = p.w_ukv + (size_t)j * KVL * 4096; c.dst = wukvt + (size_t)j * 4096 * KVL; c.ld = 4096; c.K = KVL; kt = r & 7; nt_ = r >> 3; }
        c.k0 = kt * 64; c.n0 = nt_ * 256; };
    for (int t = rank; t < nfast; t += 2 * nranks) {
        CvtTile ca, cb; decode(t, ca); const bool hb = t + nranks < nfast; decode(hb ? t + nranks : t, cb);
        cvt_tile_fast2(ca, cb, hb, tile);
    }
    if (mla) {
        for (int t = rank; t < 1024; t += nranks) {
            if (t < 640) { const int kt = t & 31, nt_ = t >> 5;
                cvt_tile_map(p.w_dq + (size_t)j * DM * QL, QL, p.w_dkv + (size_t)j * DM * (KVL + DR), KVL + DR, DM, 1, wdqkvt + (size_t)j * NDQKV * DM, kt * 64, nt_ * 64, tile); }
            else { const int r = t - 640, kt = r & 7, nt_ = r >> 3;
                cvt_tile_map(p.w_uq + (size_t)j * QL * NH * DQK, NH * DQK, nullptr, 0, QL, 2, wuqt + (size_t)j * NH * DQK * QL, kt * 64, nt_ * 64, tile); }
        }
    } else {
        for (int u = rank; u < 2 * NG; u += nranks) { const int jdg = j * 2 * NG + u; s5f::make_tables(jdg, p, p.ws + OFF_S5T + (size_t)jdg * s5f::TB_STRIDE, (char*)lds); }
    }
}
__device__ __forceinline__ void load_args(P& p) {
    KP k = kp(); p.x = k->x; p.c = k->c; p.ctx = k->ctx; p.cctx = k->cctx; p.ada_w = k->ada_w; p.ada_b = k->ada_b; p.norm1_g = k->norm1_g; p.norm2_g = k->norm2_g; p.final_g = k->final_g;
    p.lam_re = k->lam_re; p.lam_im = k->lam_im; p.log_dt = k->log_dt; p.b_re = k->b_re; p.b_im = k->b_im; p.c_re = k->c_re; p.c_im = k->c_im; p.s5_d = k->s5_d; p.w_glu = k->w_glu; p.b_glu = k->b_glu;
    p.w_dq = k->w_dq; p.q_norm = k->q_norm; p.w_uq = k->w_uq; p.w_dkv = k->w_dkv; p.kv_norm = k->kv_norm; p.w_ukv = k->w_ukv; p.w_o = k->w_o; p.ffn_w1 = k->ffn_w1; p.ffn_w2 = k->ffn_w2; p.out = k->out; p.ws = k->ws;
}
__device__ __forceinline__ void prologue_phase(unsigned char* lds) {
    P p; load_args(p);
    const int tid = ltid(), bid = lbid(), G = lgrid();
    convert_layer(0, p, bid, G, lds);
    __syncthreads();
    float* sl = (float*)lds; float* red = sl + DM * 4;
    for (int k = tid; k < DM; k += 512) { const float a = p.c[k], b = p.c[DM + k], cc = p.cctx[k];
        sl[k * 4 + 0] = a * sigmoidf_(a); sl[k * 4 + 1] = b * sigmoidf_(b); sl[k * 4 + 2] = cc * sigmoidf_(cc); sl[k * 4 + 3] = 0.f; }
    __syncthreads();
    for (int u = bid; u < 768; u += G) ada_unit(u, p.ada_w, p.ada_b, (float*)(p.ws + OFF_MOD), sl, red);
    misc_phase(p, bid * 512 + tid, G * 512);
}
__device__ __forceinline__ void convert_in_tail(const int L, const int units, unsigned char* lds) {
    const int bid = lbid(), G = lgrid(); const int extra = units % G;
    if (extra == 0) return;
    if (bid >= extra) { P p; load_args(p); __syncthreads(); convert_layer(L, p, bid - extra, G - extra, lds); }
}

struct Pend { const float* slab; const float* gate; const bf16_t* z; const float* bglu; int nS, mode; };
__device__ __forceinline__ void norm_mod_phase(float* xs, const float* rlat, const float* rctx, const float* gnorm, const float* sh, const float* sc, bf16_t* out, int M, const Pend pd) {
    const int lane = ltid() & 63, wv = lbid() * 8 + (ltid() >> 6), nw = lgrid() * 8;
    for (int row = wv; row < M; row += nw) {
        float* xp = xs + (size_t)row * DM; const float* rp = row < NLAT ? rlat + (size_t)row * DM : rctx + (size_t)(row - NLAT) * DM; f32x4 x[8]; float ss = 0.f;
#pragma unroll
        for (int i = 0; i < 8; ++i) x[i] = *(const f32x4*)(rp + i * 256 + lane * 4);
        if (pd.mode != 0 && row >= NLAT) {
#pragma unroll
            for (int i = 0; i < 8; ++i) { const int col = i * 256 + lane * 4; f32x4 a = {0.f, 0.f, 0.f, 0.f};
                for (int ks = 0; ks < pd.nS; ++ks) a += *(const f32x4*)(pd.slab + ((size_t)ks * NCTX + (row - NLAT)) * DM + col);
                const f32x4 g = *(const f32x4*)(pd.gate + col);
                if (pd.mode == 2) { const f32x4 bb = *(const f32x4*)(pd.bglu + col); const u32x2 zz = *(const u32x2*)(pd.z + (size_t)row * DM + col);
                    a[0] = __uint_as_float(zz.x << 16) * sigmoidf_(a[0] + bb[0]); a[1] = __uint_as_float(zz.x & 0xffff0000u) * sigmoidf_(a[1] + bb[1]);
                    a[2] = __uint_as_float(zz.y << 16) * sigmoidf_(a[2] + bb[2]); a[3] = __uint_as_float(zz.y & 0xffff0000u) * sigmoidf_(a[3] + bb[3]); }
                x[i] += g * a; *(f32x4*)(xp + col) = x[i]; }
        }
#pragma unroll
        for (int i = 0; i < 8; ++i) ss += x[i][0] * x[i][0] + x[i][1] * x[i][1] + x[i][2] * x[i][2] + x[i][3] * x[i][3];
        ss = wave_sum(ss); const float rs = rsqrtf(ss * (1.0f / DM) + EPS); const int r = modrow(row);
#pragma unroll
        for (int i = 0; i < 8; ++i) { const int col = i * 256 + lane * 4; const f32x4 g = *(const f32x4*)(gnorm + col), a = *(const f32x4*)(sc + r * 6 * DM + col), b = *(const f32x4*)(sh + r * 6 * DM + col);
            f32x4 y = x[i] * rs * g; y = y * (1.0f + a) + b;
            u32x2 w; w.x = pk2(y[0], y[1]); w.y = pk2(y[2], y[3]); *(u32x2*)(out + (size_t)row * DM + col) = w; }
    }
}
__device__ __forceinline__ void final_norm_phase(const float* xs, const float* g, float* out) {
    const int lane = ltid() & 63, wv = lbid() * 8 + (ltid() >> 6), nw = lgrid() * 8;
    for (int row = wv; row < NLAT; row += nw) {
        const float* xp = xs + (size_t)row * DM; f32x4 x[8]; float ss = 0.f;
#pragma unroll
        for (int i = 0; i < 8; ++i) { x[i] = *(const f32x4*)(xp + i * 256 + lane * 4); ss += x[i][0] * x[i][0] + x[i][1] * x[i][1] + x[i][2] * x[i][2] + x[i][3] * x[i][3]; }
        ss = wave_sum(ss); const float rs = rsqrtf(ss * (1.0f / DM) + EPS);
#pragma unroll
        for (int i = 0; i < 8; ++i) { const int col = i * 256 + lane * 4; *(f32x4*)(out + (size_t)row * DM + col) = x[i] * rs * *(const f32x4*)(g + col); }
    }
}
__device__ __forceinline__ void mla_mid_phase(const float* qc, const float* qnorm, const float* kvnorm, const float* rope, bf16_t* qn, bf16_t* ckvn, bf16_t* kpe, int M) {
    const int lane = ltid() & 63, wv = lbid() * 8 + (ltid() >> 6), nw = lgrid() * 8;
    for (int row = wv; row < M; row += nw) {
        const float* p = qc + (size_t)row * NDQKV;
#pragma unroll
        for (int part = 0; part < 2; ++part) {
            const f32x4 a = *(const f32x4*)(p + part * 512 + lane * 8), b = *(const f32x4*)(p + part * 512 + lane * 8 + 4);
            float ss = a[0] * a[0] + a[1] * a[1] + a[2] * a[2] + a[3] * a[3] + b[0] * b[0] + b[1] * b[1] + b[2] * b[2] + b[3] * b[3];
            ss = wave_sum(ss); const float rs = rsqrtf(ss * (1.0f / 512) + EPS);
            const float* gn = (part ? kvnorm : qnorm) + lane * 8; const f32x4 g0 = *(const f32x4*)gn, g1 = *(const f32x4*)(gn + 4);
            const f32x4 y0 = a * rs * g0, y1 = b * rs * g1;
            u32x4 w; w.x = pk2(y0[0], y0[1]); w.y = pk2(y0[2], y0[3]); w.z = pk2(y1[0], y1[1]); w.w = pk2(y1[2], y1[3]);
            *(u32x4*)((part ? ckvn : qn) + (size_t)row * 512 + lane * 8) = w; }
        int bb, key, lpos; row_bk(row, bb, key, lpos);
        float v = p[1024 + lane]; const float other = __shfl_xor(v, 1);
        if (lpos >= 0) { const int axis = lane >> 5, f = (lane & 31) >> 1; const float cs = rope[((size_t)(lpos * 2 + axis) * 16 + f) * 2], sn = rope[((size_t)(lpos * 2 + axis) * 16 + f) * 2 + 1];
            v = (lane & 1) ? (other * sn + v * cs) : (v * cs - other * sn); }
        kpe[((size_t)bb * NKEY + key) * DR + lane] = f2bf(v);
    }
}

namespace att {
typedef float f32x16 __attribute__((ext_vector_type(16)));
typedef short s16x4 __attribute__((ext_vector_type(4)));
constexpr int KVBLK = 64;
constexpr int SHM_V = KVBLK * 128 * 2, SHM_K = KVBLK * 128 * 2, SHM_P = KVBLK * 64 * 2;
constexpr int OFF_V = 0, OFF_KN = 2 * SHM_V, OFF_KP = OFF_KN + 2 * SHM_K, OFF_WS = OFF_KP + 2 * SHM_P, LDS_ATT = OFF_WS + 8 * 64 * 4;
constexpr int OST_STRIDE = 320, OST_WAVE = 32 * OST_STRIDE;
constexpr float THR2 = 11.5f;
#define ATT_KSWZ(row, colB) ((row) * 256 + ((colB) ^ (((row) & 7) << 4)))
#define ATT_PSWZ(row, colB) ((row) * 128 + ((colB) ^ ((((row) >> 1) & 7) << 4)))
#define ATT_SBAR() __builtin_amdgcn_sched_barrier(0)
__device__ __forceinline__ int crow(int r, int hi) { return (r & 3) + 8 * (r >> 2) + 4 * hi; }
__device__ __forceinline__ unsigned cvtpk(float lo, float hi) { unsigned r; asm volatile("v_cvt_pk_bf16_f32 %0, %1, %2" : "=v"(r) : "v"(lo), "v"(hi)); return r; }
__device__ __forceinline__ void partialSM(f32x16& p0, f32x16& p1, float& m_reg, float& mn, float& alpha) {
    float pmax = p0[0];
#pragma unroll
    for (int r = 1; r < 16; ++r) pmax = fmaxf(pmax, p0[r]);
#pragma unroll
    for (int r = 0; r < 16; ++r) pmax = fmaxf(pmax, p1[r]);
    { auto rr = __builtin_amdgcn_permlane32_swap(__float_as_uint(pmax), __float_as_uint(pmax), false, false);
      pmax = fmaxf(__uint_as_float(rr[0]), __uint_as_float(rr[1])); }
    if (__builtin_expect(__all(pmax - m_reg <= THR2), 1)) { mn = m_reg; alpha = 1.f; }
    else { mn = fmaxf(m_reg, pmax); alpha = __builtin_amdgcn_exp2f(m_reg - mn); m_reg = mn; }
#pragma unroll
    for (int r = 0; r < 16; ++r) p0[r] = p0[r] - mn;
#pragma unroll
    for (int r = 0; r < 16; ++r) p1[r] = p1[r] - mn;
#pragma unroll
    for (int r = 0; r < 16; ++r) p0[r] = __builtin_amdgcn_exp2f(p0[r]);
}
__device__ __forceinline__ void finishSM(f32x16& p0, f32x16& p1, float alpha, float& l_reg, bf16x8& pa0, bf16x8& pa1, bf16x8& pa2, bf16x8& pa3) {
#pragma unroll
    for (int r = 0; r < 16; ++r) p1[r] = __builtin_amdgcn_exp2f(p1[r]);
    float ps = 0;
#pragma unroll
    for (int r = 0; r < 16; ++r) ps += p0[r];
#pragma unroll
    for (int r = 0; r < 16; ++r) ps += p1[r];
    { auto rr = __builtin_amdgcn_permlane32_swap(__float_as_uint(ps), __float_as_uint(ps), false, false);
      ps = __uint_as_float(rr[0]) + __uint_as_float(rr[1]); }
    l_reg = l_reg * alpha + ps;
#define ATT_PK4(P, BASE, OUT) do { unsigned a0 = cvtpk(P[BASE + 0], P[BASE + 1]), a1 = cvtpk(P[BASE + 2], P[BASE + 3]);   \
    unsigned b0 = cvtpk(P[BASE + 4], P[BASE + 5]), b1 = cvtpk(P[BASE + 6], P[BASE + 7]);                              \
    auto r0 = __builtin_amdgcn_permlane32_swap(a0, b0, false, false); auto r1 = __builtin_amdgcn_permlane32_swap(a1, b1, false, false); \
    u32x4 w = {r0[0], r1[0], r0[1], r1[1]}; OUT = *reinterpret_cast<bf16x8*>(&w); } while (0)
    ATT_PK4(p0, 0, pa0); ATT_PK4(p0, 8, pa1); ATT_PK4(p1, 0, pa2); ATT_PK4(p1, 8, pa3);
#undef ATT_PK4
}
__device__ __forceinline__ void qkt(f32x16& p0, f32x16& p1, const char* Kn, const char* Kp, const bf16x8* qr, int r32, int hi) {
    p0 = f32x16{}; p1 = f32x16{};
#pragma unroll
    for (int d0 = 0; d0 < 8; ++d0) { const int cb = (d0 * 16 + hi * 8) * 2;
        const bf16x8 b0 = *reinterpret_cast<const bf16x8*>(Kn + ATT_KSWZ(r32, cb));
        const bf16x8 b1 = *reinterpret_cast<const bf16x8*>(Kn + ATT_KSWZ(32 + r32, cb));
        p0 = __builtin_amdgcn_mfma_f32_32x32x16_bf16(b0, qr[d0], p0, 0, 0, 0);
        p1 = __builtin_amdgcn_mfma_f32_32x32x16_bf16(b1, qr[d0], p1, 0, 0, 0); }
#pragma unroll
    for (int d0 = 0; d0 < 4; ++d0) { const int cb = (d0 * 16 + hi * 8) * 2;
        const bf16x8 b0 = *reinterpret_cast<const bf16x8*>(Kp + ATT_PSWZ(r32, cb));
        const bf16x8 b1 = *reinterpret_cast<const bf16x8*>(Kp + ATT_PSWZ(32 + r32, cb));
        p0 = __builtin_amdgcn_mfma_f32_32x32x16_bf16(b0, qr[8 + d0], p0, 0, 0, 0);
        p1 = __builtin_amdgcn_mfma_f32_32x32x16_bf16(b1, qr[8 + d0], p1, 0, 0, 0); }
}
__device__ __forceinline__ int v_st(int k, int c) { const int kk = (k & ~0xC) | ((k & 4) << 1) | ((k & 8) >> 1); return ((kk >> 3) * 4 + (c >> 5)) * 512 + ((kk & 7) * 32 + (c & 31)) * 2; }
__device__ __forceinline__ int v_rd_base(int lane) { return ((lane & 3) << 3) | (((lane >> 2) & 3) << 6) | (((lane >> 4) & 1) << 5) | (((lane >> 5) & 1) << 8); }
constexpr int v_rd_off(int d0, int ks, int half) { return d0 * 512 + ks * 4096 + half * 2048; }
template <int OFF> __device__ __forceinline__ s16x4 tr_read(int vb) { s16x4 r; asm volatile("ds_read_b64_tr_b16 %0, %1 offset:%2" : "=&v"(r) : "v"(vb), "i"(OFF) : "memory"); return r; }
template <int D0> __device__ __forceinline__ void pv_one(f32x16& od, int vb, bf16x8 pa0, bf16x8 pa1, bf16x8 pa2, bf16x8 pa3) {
    const s16x4 l0 = tr_read<v_rd_off(D0, 0, 0)>(vb), h0 = tr_read<v_rd_off(D0, 0, 1)>(vb), l1 = tr_read<v_rd_off(D0, 1, 0)>(vb), h1 = tr_read<v_rd_off(D0, 1, 1)>(vb);
    const s16x4 l2 = tr_read<v_rd_off(D0, 2, 0)>(vb), h2 = tr_read<v_rd_off(D0, 2, 1)>(vb), l3 = tr_read<v_rd_off(D0, 3, 0)>(vb), h3 = tr_read<v_rd_off(D0, 3, 1)>(vb);
    asm volatile("s_waitcnt lgkmcnt(0)" ::: "memory"); ATT_SBAR();
#define ATT_PK(L, H) (bf16x8){L[0], L[1], L[2], L[3], H[0], H[1], H[2], H[3]}
    od = __builtin_amdgcn_mfma_f32_32x32x16_bf16(pa0, ATT_PK(l0, h0), od, 0, 0, 0);
    od = __builtin_amdgcn_mfma_f32_32x32x16_bf16(pa1, ATT_PK(l1, h1), od, 0, 0, 0);
    od = __builtin_amdgcn_mfma_f32_32x32x16_bf16(pa2, ATT_PK(l2, h2), od, 0, 0, 0);
    od = __builtin_amdgcn_mfma_f32_32x32x16_bf16(pa3, ATT_PK(l3, h3), od, 0, 0, 0);
#undef ATT_PK
}
__device__ __forceinline__ void pv_d0(f32x16* o, int vb, bf16x8 pa0, bf16x8 pa1, bf16x8 pa2, bf16x8 pa3) {
    pv_one<0>(o[0], vb, pa0, pa1, pa2, pa3); pv_one<1>(o[1], vb, pa0, pa1, pa2, pa3); pv_one<2>(o[2], vb, pa0, pa1, pa2, pa3); pv_one<3>(o[3], vb, pa0, pa1, pa2, pa3);
}
__device__ __forceinline__ void attn_unit(const bf16_t* __restrict__ Qb, const bf16_t* __restrict__ Kh, const bf16_t* __restrict__ Ph, const bf16_t* __restrict__ Vh, bf16_t* __restrict__ Ob, int NT, char* lds) {
    const int tid = ltid(), wid = tid >> 6, lane = tid & 63, r32 = lane & 31, hi = lane >> 5;
    char* V_lds = lds + OFF_V; char* K_lds = lds + OFF_KN; char* P_lds = lds + OFF_KP;
    float* wsl = (float*)(lds + OFF_WS) + wid * 64; float* li_l = wsl; float* al_l = wsl + 32;
    float m_reg = -1e30f, l_reg = 0; f32x16 o[4] = {}; bf16x8 qr[12];
    const bf16_t* Qw = Qb + (size_t)(wid * 32 + r32) * DQK + hi * 8;
#pragma unroll
    for (int d0 = 0; d0 < 12; ++d0) qr[d0] = *reinterpret_cast<const bf16x8*>(Qw + d0 * 16);
    const int sr = tid >> 4, sc = (tid & 15) * 8, vst0 = v_st(sr, sc), vst1 = v_st(32 + sr, sc);
    const int pr_ = tid >> 3, pc = (tid & 7) * 16;
    const int vb0 = (int)(uintptr_t)(LAS char*)V_lds + v_rd_base(lane);
    bf16x8 vs0, vs1, ks0, ks1, ps0;
#define ATT_SLOAD(k0) do { vs0 = *reinterpret_cast<const bf16x8*>(&Vh[(size_t)((k0) + sr) * 128 + sc]); vs1 = *reinterpret_cast<const bf16x8*>(&Vh[(size_t)((k0) + 32 + sr) * 128 + sc]); \
    ks0 = *reinterpret_cast<const bf16x8*>(&Kh[(size_t)((k0) + sr) * 128 + sc]); ks1 = *reinterpret_cast<const bf16x8*>(&Kh[(size_t)((k0) + 32 + sr) * 128 + sc]); \
    ps0 = *reinterpret_cast<const bf16x8*>(&Ph[(size_t)((k0) + pr_) * 64 + (pc >> 1)]); } while (0)
#define ATT_SWRITE(b) do { *(bf16x8*)(V_lds + (b) * SHM_V + vst0) = vs0; *(bf16x8*)(V_lds + (b) * SHM_V + vst1) = vs1; const int kc = sc * 2;   \
    *(bf16x8*)(K_lds + (b) * SHM_K + ATT_KSWZ(sr, kc)) = ks0; *(bf16x8*)(K_lds + (b) * SHM_K + ATT_KSWZ(32 + sr, kc)) = ks1;                    \
    *(bf16x8*)(P_lds + (b) * SHM_P + ATT_PSWZ(pr_, pc)) = ps0; } while (0)
#define ATT_SWAIT() asm volatile("s_waitcnt vmcnt(0)" ::: "memory")
#define ATT_RESC(a) do { if (__any((a) < 1.f)) { if (hi == 0) al_l[r32] = (a); asm volatile("s_waitcnt lgkmcnt(0)" ::: "memory"); \
    _Pragma("unroll") for (int d = 0; d < 4; ++d) _Pragma("unroll") for (int r = 0; r < 16; ++r) o[d][r] *= al_l[crow(r, hi)]; } } while (0)
    f32x16 pA0, pA1, pB0, pB1; float mnA, mnB, alA, alB; bf16x8 pa0, pa1, pa2, pa3;
    ATT_SLOAD(0); ATT_SWAIT(); ATT_SWRITE(0); __syncthreads();
    qkt(pA0, pA1, K_lds, P_lds, qr, r32, hi); partialSM(pA0, pA1, m_reg, mnA, alA);
    ATT_SLOAD(KVBLK);
    ATT_SWAIT(); ATT_SWRITE(1); __syncthreads();
    for (int j = 1; j + 1 < NT; j += 2) {
        ATT_SBAR(); qkt(pB0, pB1, K_lds + SHM_K, P_lds + SHM_P, qr, r32, hi);
        finishSM(pA0, pA1, alA, l_reg, pa0, pa1, pa2, pa3); ATT_SBAR();
        ATT_SLOAD((j + 1) * KVBLK); ATT_SBAR();
        pv_d0(o, vb0, pa0, pa1, pa2, pa3); partialSM(pB0, pB1, m_reg, mnB, alB);
        __syncthreads(); ATT_SWAIT(); ATT_SWRITE(0);
        ATT_RESC(alB); __syncthreads();
        ATT_SBAR(); qkt(pA0, pA1, K_lds, P_lds, qr, r32, hi);
        finishSM(pB0, pB1, alB, l_reg, pa0, pa1, pa2, pa3); ATT_SBAR();
        ATT_SLOAD((j + 2) * KVBLK); ATT_SBAR();
        pv_d0(o, vb0 + SHM_V, pa0, pa1, pa2, pa3); partialSM(pA0, pA1, m_reg, mnA, alA);
        __syncthreads(); ATT_SWAIT(); ATT_SWRITE(1);
        ATT_RESC(alA); __syncthreads();
    }
    ATT_SBAR(); qkt(pB0, pB1, K_lds + SHM_K, P_lds + SHM_P, qr, r32, hi);
    finishSM(pA0, pA1, alA, l_reg, pa0, pa1, pa2, pa3); ATT_SBAR();
    pv_d0(o, vb0, pa0, pa1, pa2, pa3); partialSM(pB0, pB1, m_reg, mnB, alB);
    __syncthreads(); ATT_RESC(alB);
    finishSM(pB0, pB1, alB, l_reg, pa0, pa1, pa2, pa3); ATT_SBAR();
    pv_d0(o, vb0 + SHM_V, pa0, pa1, pa2, pa3);
    if (hi == 0) li_l[r32] = l_reg; asm volatile("s_waitcnt lgkmcnt(0)" ::: "memory");
    float rli[16];
#pragma unroll
    for (int r = 0; r < 16; ++r) rli[r] = __builtin_amdgcn_rcpf(li_l[crow(r, hi)]);
    __syncthreads();
    char* ost = lds + wid * OST_WAVE; const int odd = lane & 1;
#pragma unroll
    for (int d0 = 0; d0 < 4; ++d0)
#pragma unroll
        for (int r = 0; r < 16; r += 2) {
            const float ve = o[d0][r] * rli[r], vo = o[d0][r + 1] * rli[r + 1];
            const float recv = __shfl_xor(odd ? ve : vo, 1);
            const float lo = odd ? recv : ve, hh = odd ? vo : recv;
            const int row = crow(odd ? r + 1 : r, hi);
            *(unsigned*)(ost + row * OST_STRIDE + (32 * d0 + (r32 & ~1)) * 2) = cvtpk(lo, hh);
        }
    asm volatile("s_waitcnt lgkmcnt(0)" ::: "memory");
#pragma unroll
    for (int i = 0; i < 8; ++i) { const int id = lane + 64 * i, row = id >> 4, ch = id & 15;
        const u32x4 w = *(const u32x4*)(ost + row * OST_STRIDE + ch * 16);
        *(u32x4*)(Ob + (size_t)(wid * 32 + row) * DM + ch * 8) = w; }
    __syncthreads();
#undef ATT_SLOAD
#undef ATT_SWRITE
#undef ATT_SWAIT
#undef ATT_RESC
}
__device__ __forceinline__ void attn_phase(const bf16_t* Q, const bf16_t* K, const bf16_t* Kpe, const bf16_t* V, bf16_t* out, bool with_ctx, char* lds) {
    const int nu = 512 + (with_ctx ? 32 : 0);
    for (int u = lbid(); u < nu; u += lgrid()) {
        if (u < 512) { int bh = u >> 4, qb = u & 15;
            if (lgrid() == 256) { const int c = u & 255, rnd = u >> 8, idx = c >> 3; bh = rnd * 16 + (c & 7) * 2 + (idx >> 4); qb = idx & 15; }
            const int b = bh >> 4, h = bh & 15;
            attn_unit(Q + ((size_t)bh * NKEY + CTX + qb * 256) * DQK, K + (size_t)bh * NKEY * DN, Kpe + (size_t)b * NKEY * DR, V + (size_t)bh * NKEY * DV,
                      out + (size_t)(b * SEQ + qb * 256) * DM + h * DV, NKEY / KVBLK, lds); }
        else { const int bh = u - 512, b = bh >> 4, h = bh & 15;
            attn_unit(Q + (size_t)bh * NKEY * DQK, K + (size_t)bh * NKEY * DN, Kpe + (size_t)b * NKEY * DR, V + (size_t)bh * NKEY * DV,
                      out + (size_t)(NLAT + b * CTX) * DM + h * DV, CTX / KVBLK, lds); }
    }
}
}

template <class Epi> __device__ __forceinline__ void gemm_call(unsigned char* lds, const bf16_t* A, const bf16_t* Bt, int M, int N, int K, const Epi& E) {
    pg8::Gemm g; g.A = A; g.Bt = Bt; g.M = M; g.N = N; g.K = K; g.lda = K; g.ldb = K;
    pg8::StaticOrder S; S.init(M, N, lgrid(), lbid());
    pg8::gemm_phase<Epi, pg8::StaticOrder>((LAS unsigned char*)lds, g, S, E);
}
template <class Epi> __device__ __forceinline__ void gemm_call_splitk(unsigned char* lds, const bf16_t* A, const bf16_t* Bt, int M, int N, int K, int nS, const Epi& E) {
    pg8::Gemm g; g.A = A; g.Bt = Bt; g.M = M; g.N = N; g.K = K / nS; g.lda = K; g.ldb = K;
    pg8::SplitOrder S; S.init(M, N, nS, lgrid(), lbid());
    pg8::gemm_phase<Epi, pg8::SplitOrder>((LAS unsigned char*)lds, g, S, E);
}
template <int PR> __device__ __forceinline__ void layer_pair(unsigned char* shm, const XcdBarrier& bar) {
#define GSYNC() xcd_barrier(bar)
#define MODL(k, i) ((const float*)((k)->ws + OFF_MOD) + (size_t)(i) * 3 * 6 * DM)
#define SLAB(ws) ((float*)((ws) + OFF_YF))
    const float qscale = 0.07216878364870322f * 1.4426950408889634f;
    constexpr int NS_DOWN = 16, NS_MIX = 4;
    { constexpr int i = 2 * PR, j = PR;
      { KP k = kp(); char* ws = k->ws; const float* modl = MODL(k, i);
        Pend pd; pd.slab = SLAB(ws); pd.gate = MODL(k, i - 1) + 5 * DM + 2 * 6 * DM; pd.z = nullptr; pd.bglu = nullptr; pd.nS = NS_DOWN; pd.mode = i > 0 ? 1 : 0;
        norm_mod_phase((float*)(ws + OFF_XS), i == 0 ? k->x : (const float*)(ws + OFF_XS), i == 0 ? k->ctx : (const float*)(ws + OFF_XS) + (size_t)NLAT * DM, k->norm1_g + (size_t)i * DM, modl + 0 * DM, modl + 1 * DM, (bf16_t*)(ws + OFF_ABUF), MROWS, pd); }
      GSYNC();
      { KP k = kp(); char* ws = k->ws;
        for (int u = lbid(); u < NG * NB; u += lgrid()) s5f::unit(u >> 1, u & 1, j, (const bf16_t*)(ws + OFF_ABUF), ws + OFF_S5T, k->s5_d + (size_t)j * DM, (float*)(ws + OFF_YF), (bf16_t*)(ws + OFF_ZBUF), (char*)shm); }
      GSYNC();
      { KP k = kp(); char* ws = k->ws; Epi4<FGlu> e; e.f.xs = (float*)(ws + OFF_XS); e.f.xr = i == 0 ? k->x : (const float*)(ws + OFF_XS); e.f.g = MODL(k, i) + 2 * DM; e.f.z = (const bf16_t*)(ws + OFF_ZBUF); e.f.bglu = k->b_glu + (size_t)j * DM;
        gemm_call(shm, (const bf16_t*)(ws + OFF_ZBUF), (const bf16_t*)(ws + OFF_WGLUT) + (size_t)j * DM * DM, NLAT, DM, DM, e); }
      { KP k = kp(); char* ws = k->ws; EpiSlab e; e.C = SLAB(ws); e.ldc = DM; e.slab = (size_t)NCTX * DM;
        gemm_call_splitk(shm, (const bf16_t*)(ws + OFF_ZBUF) + (size_t)NLAT * DM, (const bf16_t*)(ws + OFF_WGLUT) + (size_t)j * DM * DM, NCTX, DM, DM, NS_MIX, e); }
      GSYNC();
      { KP k = kp(); char* ws = k->ws; const float* modl = MODL(k, i);
        Pend pd; pd.slab = SLAB(ws); pd.gate = modl + 2 * DM + 2 * 6 * DM; pd.z = (const bf16_t*)(ws + OFF_ZBUF); pd.bglu = k->b_glu + (size_t)j * DM; pd.nS = NS_MIX; pd.mode = 2;
        norm_mod_phase((float*)(ws + OFF_XS), (const float*)(ws + OFF_XS), i == 0 ? k->ctx : (const float*)(ws + OFF_XS) + (size_t)NLAT * DM, k->norm2_g + (size_t)i * DM, modl + 3 * DM, modl + 4 * DM, (bf16_t*)(ws + OFF_ABUF), MROWS, pd); }
      GSYNC();
      { KP k = kp(); char* ws = k->ws; Epi8<FUp> e; e.f.h = (bf16_t*)(ws + OFF_HBUF); gemm_call(shm, (const bf16_t*)(ws + OFF_ABUF), (const bf16_t*)(ws + OFF_W1T) + (size_t)i * DFF * DM, MROWS, DFF, DM, e); }
      convert_in_tail(i + 1, (MROWS / 256) * (DFF / 256), shm);
      if (PROBE == 11 || PROBE == 12) { KP k = kp(); char* ws = k->ws; Epi8<FUp> e; e.f.h = (bf16_t*)(ws + OFF_YF); __syncthreads();
        gemm_call(shm, (const bf16_t*)(ws + OFF_ABUF), (const bf16_t*)(ws + OFF_W1T) + (size_t)(PROBE == 11 ? i : (i + 2) % 4) * DFF * DM, 4096, DFF / 2, DM, e); }
      GSYNC();
      { KP k = kp(); char* ws = k->ws; Epi4<FRes> e; e.f.xs = (float*)(ws + OFF_XS); e.f.g = MODL(k, i) + 5 * DM; gemm_call(shm, (const bf16_t*)(ws + OFF_HBUF), (const bf16_t*)(ws + OFF_W2T) + (size_t)i * DM * DFF, NLAT, DM, DFF, e); }
      { KP k = kp(); char* ws = k->ws; EpiSlab e; e.C = SLAB(ws); e.ldc = DM; e.slab = (size_t)NCTX * DM;
        gemm_call_splitk(shm, (const bf16_t*)(ws + OFF_HBUF) + (size_t)NLAT * DFF, (const bf16_t*)(ws + OFF_W2T) + (size_t)i * DM * DFF, NCTX, DM, DFF, NS_DOWN, e); }
      GSYNC();
    }
    { constexpr int i = 2 * PR + 1, j = PR; constexpr bool last = (i == DEPTH - 1); constexpr int M = last ? NLAT : MROWS;
      { KP k = kp(); char* ws = k->ws; const float* modl = MODL(k, i);
        Pend pd; pd.slab = SLAB(ws); pd.gate = MODL(k, i - 1) + 5 * DM + 2 * 6 * DM; pd.z = nullptr; pd.bglu = nullptr; pd.nS = NS_DOWN; pd.mode = 1;
        norm_mod_phase((float*)(ws + OFF_XS), (const float*)(ws + OFF_XS), (const float*)(ws + OFF_XS) + (size_t)NLAT * DM, k->norm1_g + (size_t)i * DM, modl + 0 * DM, modl + 1 * DM, (bf16_t*)(ws + OFF_ABUF), MROWS, pd); }
      GSYNC();
      { KP k = kp(); char* ws = k->ws; Epi4<FF32> e; e.f.C = (float*)(ws + OFF_QC); e.f.ldc = NDQKV; gemm_call(shm, (const bf16_t*)(ws + OFF_ABUF), (const bf16_t*)(ws + OFF_WDQKVT) + (size_t)j * NDQKV * DM, MROWS, NDQKV, DM, e); }
      GSYNC();
      { KP k = kp(); char* ws = k->ws;
        mla_mid_phase((const float*)(ws + OFF_QC), k->q_norm + (size_t)j * QL, k->kv_norm + (size_t)j * KVL, (const float*)(ws + OFF_ROPE), (bf16_t*)(ws + OFF_QN), (bf16_t*)(ws + OFF_CKVN), (bf16_t*)(ws + OFF_KPE), MROWS); }
      GSYNC();
      { KP k = kp(); char* ws = k->ws; Epi8<FUq> e; e.f.Q = (bf16_t*)(ws + OFF_Q); e.f.rope = (const float*)(ws + OFF_ROPE); e.f.qscale = qscale;
        gemm_call(shm, (const bf16_t*)(ws + OFF_QN), (const bf16_t*)(ws + OFF_WUQT) + (size_t)j * NH * DQK * QL, M, NH * DQK, QL, e); }
      { KP k = kp(); char* ws = k->ws; Epi8<FUkv> e; e.f.Kb = (bf16_t*)(ws + OFF_K); e.f.Vb = (bf16_t*)(ws + OFF_V);
        gemm_call(shm, (const bf16_t*)(ws + OFF_CKVN), (const bf16_t*)(ws + OFF_WUKVT) + (size_t)j * NH * (DN + DV) * KVL, MROWS, NH * (DN + DV), KVL, e); }
      GSYNC();
      { KP k = kp(); char* ws = k->ws;
        att::attn_phase((const bf16_t*)(ws + OFF_Q), (const bf16_t*)(ws + OFF_K), (const bf16_t*)(ws + OFF_KPE), (const bf16_t*)(ws + OFF_V), (bf16_t*)(ws + OFF_ABUF), !last, (char*)shm); }
      GSYNC();
      { KP k = kp(); char* ws = k->ws; Epi4<FRes> e; e.f.xs = (float*)(ws + OFF_XS); e.f.g = MODL(k, i) + 2 * DM; gemm_call(shm, (const bf16_t*)(ws + OFF_ABUF), (const bf16_t*)(ws + OFF_WOT) + (size_t)j * DM * DM, NLAT, DM, DM, e); }
      if (!last) { KP k = kp(); char* ws = k->ws; EpiSlab e; e.C = SLAB(ws); e.ldc = DM; e.slab = (size_t)NCTX * DM;
        gemm_call_splitk(shm, (const bf16_t*)(ws + OFF_ABUF) + (size_t)NLAT * DM, (const bf16_t*)(ws + OFF_WOT) + (size_t)j * DM * DM, NCTX, DM, DM, NS_MIX, e); }
      GSYNC();
      { KP k = kp(); char* ws = k->ws; const float* modl = MODL(k, i);
        Pend pd; pd.slab = SLAB(ws); pd.gate = modl + 2 * DM + 2 * 6 * DM; pd.z = nullptr; pd.bglu = nullptr; pd.nS = NS_MIX; pd.mode = last ? 0 : 1;
        norm_mod_phase((float*)(ws + OFF_XS), (const float*)(ws + OFF_XS), (const float*)(ws + OFF_XS) + (size_t)NLAT * DM, k->norm2_g + (size_t)i * DM, modl + 3 * DM, modl + 4 * DM, (bf16_t*)(ws + OFF_ABUF), M, pd); }
      GSYNC();
      { KP k = kp(); char* ws = k->ws; Epi8<FUp> e; e.f.h = (bf16_t*)(ws + OFF_HBUF); gemm_call(shm, (const bf16_t*)(ws + OFF_ABUF), (const bf16_t*)(ws + OFF_W1T) + (size_t)i * DFF * DM, M, DFF, DM, e); }
      if (!last) convert_in_tail(i + 1, (M / 256) * (DFF / 256), shm);
      GSYNC();
      { KP k = kp(); char* ws = k->ws; Epi4<FRes> e; e.f.xs = (float*)(ws + OFF_XS); e.f.g = MODL(k, i) + 5 * DM; gemm_call(shm, (const bf16_t*)(ws + OFF_HBUF), (const bf16_t*)(ws + OFF_W2T) + (size_t)i * DM * DFF, NLAT, DM, DFF, e); }
      if (!last) { KP k = kp(); char* ws = k->ws; EpiSlab e; e.C = SLAB(ws); e.ldc = DM; e.slab = (size_t)NCTX * DM;
        gemm_call_splitk(shm, (const bf16_t*)(ws + OFF_HBUF) + (size_t)NLAT * DFF, (const bf16_t*)(ws + OFF_W2T) + (size_t)i * DM * DFF, NCTX, DM, DFF, NS_DOWN, e); }
      GSYNC();
    }
#undef GSYNC
#undef MODL
#undef SLAB
}
__global__ void __launch_bounds__(512, 2) mega(P p_unused) {
    extern __shared__ __attribute__((aligned(16))) unsigned char shm[];
    if (threadIdx.x < 4) ((unsigned*)(shm + LDS_CTL))[threadIdx.x] = 0u;
    ltid_setup();
    __syncthreads();
    XcdBarrier bar = xcd_barrier_post((unsigned*)(kp()->ws + OFF_BAR), (volatile LAS unsigned*)(shm + LDS_CTL));
    prologue_phase(shm);
    xcd_barrier(bar);
    layer_pair<0>(shm, bar);
    layer_pair<1>(shm, bar);
#if PROBE == 10
    prologue_phase(shm);
    xcd_barrier(bar);
    layer_pair<0>(shm, bar);
    layer_pair<1>(shm, bar);
#endif
    { KP k = kp(); final_norm_phase((const float*)(k->ws + OFF_XS), k->final_g, k->out); }
}

extern "C" void kernel_launch(void* const* d_in, const int* in_sizes, int n_in, void* d_out, int out_size, void* d_ws, size_t ws_size, hipStream_t stream) {
    if (n_in != 28 || ws_size < WS_END) { fprintf(stderr, "kernel_launch: unexpected inputs (%d) or workspace (%zu < %zu)\n", n_in, ws_size, (size_t)WS_END); return; }
    static int grid = 0;
    if (!grid) {
        int dev = 0, cus = 0, per_cu = 0;
        (void)hipGetDevice(&dev); (void)hipDeviceGetAttribute(&cus, hipDeviceAttributeMultiprocessorCount, dev);
        if (hipFuncSetAttribute((const void*)mega, hipFuncAttributeMaxDynamicSharedMemorySize, LDS_BYTES) != hipSuccess) { fprintf(stderr, "kernel_launch: hipFuncSetAttribute failed\n"); return; }
        if (hipOccupancyMaxActiveBlocksPerMultiprocessor(&per_cu, (const void*)mega, 512, LDS_BYTES) != hipSuccess || per_cu < 1) fprintf(stderr, "kernel_launch: occupancy query says %d blocks per CU\n", per_cu);
        grid = cus > 0 ? cus : 256;
    }
    P p; memset(&p, 0, sizeof(p));
    const float** fp = (const float**)&p;
    for (int i = 0; i < 28; ++i) fp[i] = (const float*)d_in[i];
    p.out = (float*)d_out; p.ws = (char*)d_ws;
    (void)hipMemsetAsync(p.ws + OFF_BAR, 0, XCD_BAR_WORDS * sizeof(unsigned), stream);
    hipLaunchKernelGGL(mega, dim3(grid), dim3(512), LDS_BYTES, stream, p);
    const hipError_t le = hipPeekAtLastError();
    if (le != hipSuccess) fprintf(stderr, "kernel_launch: launch failed: %s\n", hipGetErrorName(le));
}
```
